# Optimizing an MI355X kernel written in HIP

```python
import math
import jax
import jax.numpy as jnp
from jax import lax
import numpy as np

D_MODEL = 1024
BATCH = 8
SEQ = 4096
DEPTH = 2

HEAD_DIM = 64
SCALE = HEAD_DIM ** -0.5
NEG_INF = -1e30
EPS = 1e-6
A_GROUPS = ((128, 1), (512, 4), (2048, 16))
A_HEADS_PER_GROUP = 4
A_HEADS = A_HEADS_PER_GROUP * len(A_GROUPS)
A_WIDTH = A_HEADS * HEAD_DIM
A_OUT = A_HEADS_PER_GROUP * HEAD_DIM
A_BLOCK = max(w // d for w, d in A_GROUPS)
LRU_WIDTH = D_MODEL // 2
LRU_BLOCKS = 8
LRU_BLOCK_DIM = LRU_WIDTH // LRU_BLOCKS
CONV_WIDTH = 4
LRU_C = 8.0
C_HEADS = 8
C_WIDTH = C_HEADS * HEAD_DIM
MOBA_BLOCK = 256
MOBA_TOPK = 3
MOBA_Q_CHUNK = 32
REL_BUCKETS = 32
REL_MAX_DIST = 2048
REL_HEADS = A_HEADS + C_HEADS
FFN_HIDDEN = -(-8 * D_MODEL // (3 * 256)) * 256
IN_SIZES = (A_WIDTH, A_WIDTH, A_WIDTH, LRU_WIDTH, LRU_WIDTH, C_WIDTH, C_WIDTH, C_WIDTH, 3 * D_MODEL)
IN_COLS = sum(IN_SIZES)

kernel_name = "hybrid_dilated_rglru_moba_block"


def rms_norm(x, g):
    xf = x.astype(jnp.float32)
    y = xf * lax.rsqrt(jnp.mean(xf * xf, axis=-1, keepdims=True) + EPS)
    return (y * g.astype(jnp.float32)).astype(x.dtype)


def rel_bucket(dist):
    max_exact = REL_BUCKETS // 2
    d = jnp.maximum(dist, 0)
    df = jnp.maximum(d, 1).astype(jnp.float32)
    large = max_exact + (jnp.log(df / max_exact) / math.log(REL_MAX_DIST / max_exact)
                         * (REL_BUCKETS - max_exact)).astype(jnp.int32)
    large = jnp.minimum(large, REL_BUCKETS - 1)
    return jnp.where(d < max_exact, d, large)


def dilated_window_attention(q, k, v, dilation, n_back, bias_tab):
    B, S, H, E = q.shape
    L = S // dilation
    nb = -(-L // A_BLOCK)
    Lp = nb * A_BLOCK

    def to_sub(t):
        t = t.reshape(B, L, dilation, H, E).transpose(0, 2, 3, 1, 4)
        t = jnp.pad(t, ((0, 0), (0, 0), (0, 0), (0, Lp - L), (0, 0)))
        return t.reshape(B, dilation, H, nb, A_BLOCK, E)

    qb, kb, vb = to_sub(q), to_sub(k), to_sub(v)

    def with_prev(t):
        prev = jnp.pad(t, ((0, 0), (0, 0), (0, 0), (1, 0), (0, 0), (0, 0)))[:, :, :, :nb]
        return jnp.concatenate([prev, t], axis=4)

    kk, vv = with_prev(kb), with_prev(vb)
    qi = jnp.arange(A_BLOCK)[:, None] + A_BLOCK
    kj = jnp.arange(2 * A_BLOCK)[None, :]
    delta = qi - kj
    band = (delta >= 0) & (delta <= n_back)
    has_prev = (jnp.arange(nb)[:, None, None] > 0) | (kj >= A_BLOCK)[None]
    valid = band[None] & has_prev
    bias = bias_tab.astype(jnp.float32)[rel_bucket(delta * dilation)]
    bias = jnp.transpose(bias, (2, 0, 1))
    logits = jnp.einsum('bdhnqe,bdhnke->bdhnqk', qb, kk).astype(jnp.float32) * SCALE
    logits = logits + bias[None, None, :, None]
    logits = jnp.where(valid[None, None, None], logits, NEG_INF)
    m = jnp.max(logits, axis=-1, keepdims=True)
    p = jnp.exp(logits - m)
    den = jnp.sum(p, axis=-1, keepdims=True)
    o = jnp.einsum('bdhnqk,bdhnke->bdhnqe', p, vv.astype(jnp.float32)) / den
    lse = (m + jnp.log(den))[..., 0]
    o = o.reshape(B, dilation, H, Lp, E)[:, :, :, :L].transpose(0, 3, 1, 2, 4).reshape(B, S, H, E)
    lse = lse.reshape(B, dilation, H, Lp)[:, :, :, :L].transpose(0, 3, 1, 2).reshape(B, S, H)
    return o, lse


def rg_lru_branch(xb, gb, conv_w, conv_b, w_a, b_a, w_x, b_x, lam):
    B, S, W = xb.shape
    xp = jnp.pad(xb, ((0, 0), (CONV_WIDTH - 1, 0), (0, 0)))
    xc = conv_b
    for i in range(CONV_WIDTH):
        xc = xc + xp[:, i:i + S] * conv_w[i]
    xr = xc.reshape(B, S, LRU_BLOCKS, LRU_BLOCK_DIM)
    r = jax.nn.sigmoid((jnp.einsum('bsnd,nde->bsne', xr, w_a).reshape(B, S, W) + b_a).astype(jnp.float32))
    ig = jax.nn.sigmoid((jnp.einsum('bsnd,nde->bsne', xr, w_x).reshape(B, S, W) + b_x).astype(jnp.float32))
    log_a = -LRU_C * r * jax.nn.softplus(-lam.astype(jnp.float32))
    a = jnp.exp(log_a)
    bterm = jnp.sqrt(-jnp.expm1(2.0 * log_a)) * (ig * xc.astype(jnp.float32))

    def combine(left, right):
        a1, b1 = left
        a2, b2 = right
        return a1 * a2, a2 * b1 + b2

    _, h = lax.associative_scan(combine, (a, bterm), axis=1)
    return (h * jax.nn.gelu(gb.astype(jnp.float32))).astype(xb.dtype)


def moba_attention(q, k, v, bias_tab):
    B, S, H, E = q.shape
    f32 = jnp.float32
    nblk = -(-S // MOBA_BLOCK)
    Sp = nblk * MOBA_BLOCK
    pad = ((0, 0), (0, 0), (0, Sp - S), (0, 0))
    qh = q.transpose(0, 2, 1, 3)
    qb = jnp.pad(qh, pad).reshape(B, H, nblk, MOBA_BLOCK, E)
    kb = jnp.pad(k.transpose(0, 2, 1, 3), pad).reshape(B, H, nblk, MOBA_BLOCK, E)
    vb = jnp.pad(v.transpose(0, 2, 1, 3), pad).reshape(B, H, nblk, MOBA_BLOCK, E)
    tab = bias_tab.astype(f32)
    off = jnp.arange(MOBA_BLOCK)
    delta = off[:, None] - off[None, :]
    bias_own = jnp.transpose(tab[rel_bucket(delta)], (2, 0, 1))
    lg = jnp.einsum('bhnqe,bhnke->bhnqk', qb, kb).astype(f32) * SCALE + bias_own[None, :, None]
    lg = jnp.where(delta >= 0, lg, NEG_INF)
    m_own = jnp.max(lg, axis=-1)
    p = jnp.exp(lg - m_own[..., None])
    den_own = jnp.sum(p, axis=-1).reshape(B, H, Sp)[:, :, :S]
    num_own = jnp.einsum('bhnqk,bhnke->bhnqe', p, vb.astype(f32)).reshape(B, H, Sp, E)[:, :, :S]
    m_own = m_own.reshape(B, H, Sp)[:, :, :S]
    n_sel = min(MOBA_TOPK, nblk - 1)
    if n_sel == 0:
        out = num_own / den_own[..., None]
    else:
        kmean = jnp.mean(kb.astype(f32), axis=3)
        qpos = jnp.arange(S)
        qblk = qpos // MOBA_BLOCK
        gate = jnp.einsum('bhse,bhne->bhsn', qh.astype(f32), kmean)
        gate = jnp.where(jnp.arange(nblk)[None, :] < qblk[:, None], gate, NEG_INF)
        _, idx = lax.top_k(gate, n_sel)
        base = (jnp.arange(B)[:, None] * H + jnp.arange(H)[None, :]) * nblk
        fidx = idx + base[:, :, None, None]
        kflat = kb.reshape(B * H * nblk, MOBA_BLOCK, E)
        vflat = vb.reshape(B * H * nblk, MOBA_BLOCK, E)
        head = jnp.arange(H)[None, :, None, None, None]
        tab_t = tab.T
        nq = S // MOBA_Q_CHUNK

        def chunks(t):
            return jnp.moveaxis(t.reshape(B, H, nq, MOBA_Q_CHUNK, *t.shape[3:]), 2, 0)

        def step(args):
            qc, fi, bi, qp, m_o, d_o, n_o = args
            ks = jnp.take(kflat, fi, axis=0)
            vs = jnp.take(vflat, fi, axis=0)
            lgs = jnp.einsum('bhqe,bhqnke->bhqnk', qc, ks).astype(f32) * SCALE
            kpos = bi[..., None] * MOBA_BLOCK + jnp.arange(MOBA_BLOCK)
            lgs = lgs + tab_t[head, rel_bucket(qp[:, None, None] - kpos)]
            ok = bi < (qp // MOBA_BLOCK)[:, None]
            lgs = jnp.where(ok[..., None], lgs, NEG_INF)
            mm = jnp.maximum(jnp.max(lgs, axis=(-2, -1)), m_o)
            ps = jnp.exp(lgs - mm[..., None, None])
            c_o = jnp.exp(m_o - mm)
            den = d_o * c_o + jnp.sum(ps, axis=(-2, -1))
            num = n_o * c_o[..., None] + jnp.einsum('bhqnk,bhqnke->bhqe', ps, vs.astype(f32))
            return num / den[..., None]

        out = lax.map(step, (chunks(qh), chunks(fidx), chunks(idx), qpos.reshape(nq, MOBA_Q_CHUNK),
                             chunks(m_own), chunks(den_own), chunks(num_own)))
        out = jnp.moveaxis(out, 0, 2).reshape(B, H, S, E)
    return out.transpose(0, 2, 1, 3)


def hybrid_layer(x, rel_bias, g_mix, w_in, conv_w, conv_b, lru_wa, lru_ba, lru_wx, lru_bx, lru_lam,
                 p_a, p_b, p_c, w_out, g_ffn, w_gu, w_down):
    B, S, D = x.shape
    h = rms_norm(x, g_mix)
    z = h @ w_in
    offs = np.cumsum(IN_SIZES)[:-1].tolist()
    qa, ka, va, xb, gb, qc, kc, vc, gates = jnp.split(z, offs, axis=-1)
    qa = qa.reshape(B, S, A_HEADS, HEAD_DIM)
    ka = ka.reshape(B, S, A_HEADS, HEAD_DIM)
    va = va.reshape(B, S, A_HEADS, HEAD_DIM)
    outs, lses = [], []
    for g, (window, dilation) in enumerate(A_GROUPS):
        sl = slice(g * A_HEADS_PER_GROUP, (g + 1) * A_HEADS_PER_GROUP)
        o, lse = dilated_window_attention(qa[:, :, sl], ka[:, :, sl], va[:, :, sl],
                                          dilation, window // dilation, rel_bias[:, sl])
        outs.append(o)
        lses.append(lse)
    wts = jax.nn.softmax(jnp.stack(lses, axis=0), axis=0)
    o_a = jnp.sum(wts[..., None] * jnp.stack(outs, axis=0), axis=0).reshape(B, S, A_OUT).astype(x.dtype)
    o_b = rg_lru_branch(xb, gb, conv_w, conv_b, lru_wa, lru_ba, lru_wx, lru_bx, lru_lam)
    o_c = moba_attention(qc.reshape(B, S, C_HEADS, HEAD_DIM), kc.reshape(B, S, C_HEADS, HEAD_DIM),
                         vc.reshape(B, S, C_HEADS, HEAD_DIM), rel_bias[:, A_HEADS:])
    o_c = o_c.reshape(B, S, C_WIDTH).astype(x.dtype)
    gt = jax.nn.sigmoid(gates.astype(jnp.float32)).astype(x.dtype).reshape(B, S, 3, D)
    merged = gt[:, :, 0] * (o_a @ p_a) + gt[:, :, 1] * (o_b @ p_b) + gt[:, :, 2] * (o_c @ p_c)
    x = x + merged @ w_out
    u = rms_norm(x, g_ffn) @ w_gu
    gate, up = jnp.split(u, 2, axis=-1)
    return x + (jax.nn.silu(gate) * up) @ w_down


def setup_inputs(seed: int = 0) -> dict:
    key = jax.random.key(seed)
    ks = jax.random.split(key, 24)
    f32 = jnp.float32

    def nrm(k, shape, scale):
        return jax.random.normal(k, shape, f32) * scale

    u = jax.random.uniform(ks[11], (DEPTH, LRU_WIDTH), f32, 0.9, 0.999)
    a = u ** (1.0 / LRU_C)
    return {
        "x": nrm(ks[0], (BATCH, SEQ, D_MODEL), 1.0),
        "rel_bias": nrm(ks[1], (REL_BUCKETS, REL_HEADS), 0.5),
        "g_mix": 1.0 + nrm(ks[2], (DEPTH, D_MODEL), 0.05),
        "w_in": nrm(ks[3], (DEPTH, D_MODEL, IN_COLS), D_MODEL ** -0.5),
        "conv_w": nrm(ks[4], (DEPTH, CONV_WIDTH, LRU_WIDTH), CONV_WIDTH ** -0.5),
        "conv_b": nrm(ks[5], (DEPTH, LRU_WIDTH), 0.02),
        "lru_wa": nrm(ks[6], (DEPTH, LRU_BLOCKS, LRU_BLOCK_DIM, LRU_BLOCK_DIM), LRU_BLOCK_DIM ** -0.5),
        "lru_ba": nrm(ks[7], (DEPTH, LRU_WIDTH), 0.02),
        "lru_wx": nrm(ks[8], (DEPTH, LRU_BLOCKS, LRU_BLOCK_DIM, LRU_BLOCK_DIM), LRU_BLOCK_DIM ** -0.5),
        "lru_bx": nrm(ks[9], (DEPTH, LRU_WIDTH), 0.02),
        "lru_lam": jnp.log(a) - jnp.log1p(-a),
        "p_a": nrm(ks[12], (DEPTH, A_OUT, D_MODEL), A_OUT ** -0.5),
        "p_b": nrm(ks[13], (DEPTH, LRU_WIDTH, D_MODEL), LRU_WIDTH ** -0.5),
        "p_c": nrm(ks[14], (DEPTH, C_WIDTH, D_MODEL), C_WIDTH ** -0.5),
        "w_out": nrm(ks[15], (DEPTH, D_MODEL, D_MODEL), D_MODEL ** -0.5),
        "g_ffn": 1.0 + nrm(ks[16], (DEPTH, D_MODEL), 0.05),
        "w_gu": nrm(ks[17], (DEPTH, D_MODEL, 2 * FFN_HIDDEN), D_MODEL ** -0.5),
        "w_down": nrm(ks[18], (DEPTH, FFN_HIDDEN, D_MODEL), FFN_HIDDEN ** -0.5),
        "g_final": 1.0 + nrm(ks[19], (D_MODEL,), 0.05),
    }


def reference(x, rel_bias, g_mix, w_in, conv_w, conv_b, lru_wa, lru_ba, lru_wx, lru_bx, lru_lam,
              p_a, p_b, p_c, w_out, g_ffn, w_gu, w_down, g_final):
    for l in range(DEPTH):
        x = hybrid_layer(x, rel_bias, g_mix[l], w_in[l], conv_w[l], conv_b[l], lru_wa[l], lru_ba[l],
                         lru_wx[l], lru_bx[l], lru_lam[l], p_a[l], p_b[l], p_c[l], w_out[l],
                         g_ffn[l], w_gu[l], w_down[l])
    return rms_norm(x, g_final)
```

```cpp
#include <hip/hip_runtime.h>
#include <hip/hip_cooperative_groups.h>
#include <cstdio>
#include <cstdint>
namespace cg = cooperative_groups;
namespace pg8 {
#define PG8_LAS __attribute__((address_space(3)))
typedef unsigned short bf16_t;
typedef short bf16x8 __attribute__((ext_vector_type(8)));
typedef float f32x4 __attribute__((ext_vector_type(4)));
typedef unsigned u32x4 __attribute__((ext_vector_type(4)));
constexpr int BM = 256, BK = 64, HALF = 128, HTB = HALF * BK * 2  , STAGE_BYTES = 8 * HTB, NXCD = 8, WGM = 8;

__host__ __device__ __forceinline__ int lds_byte(int r, int c) { const int st = (r >> 4) * 2 + (c >> 5), rr = r & 15, cc = c & 31, ob = rr * 64 + cc * 2; return st * 1024 + (ob ^ (((ob >> 9) & 1) << 5)); }
__host__ __device__ __forceinline__ void stage_rc(int b, int& R, int& C) { const int st = b / 1024, sb = b % 1024, swz = sb ^ (((sb >> 9) & 1) << 5); R = (st >> 1) * 16 + swz / 64; C = (st & 1) * 32 + (swz % 64) / 2; }
__host__ __device__ __forceinline__ int perm32(int rho) { const int n = rho >> 4, i = rho & 15; return 8 * (i >> 2) + 4 * n + (i & 3); }

struct Unit { int pm, pn; };
struct Gemm { const bf16_t* A; const bf16_t* Bt; int M, N, K; };

struct StaticOrder {
    int nM, nN, nwg, G, c;
    __host__ __device__ void init(int M, int N, int G_, int c_) { nM = M / BM; nN = N / BM; nwg = nM * nN; G = G_; c = c_; }
    __host__ __device__ bool next(int i, Unit& u) const {
        const long L = (long)i * G + c; if (L >= nwg) return false;
        int wgid = (int)L; { const int q = nwg / NXCD, r = nwg % NXCD, xcd = wgid % NXCD, off = wgid / NXCD; wgid = (xcd < r ? xcd * (q + 1) : r * (q + 1) + (xcd - r) * q) + off; }
        const int nig = WGM * nN, gid = wgid / nig, fm = gid * WGM, gsz = (nM - fm) < WGM ? (nM - fm) : WGM;
        u.pm = fm + ((wgid % nig) % gsz); u.pn = (wgid % nig) / gsz; return true;
    }
    __device__ __forceinline__ void a_ready(const Unit&) const {}
    __device__ __forceinline__ void done(const Unit&) const {}
    __device__ __forceinline__ size_t aoff(const Unit&) const { return 0; }
    __device__ __forceinline__ int nt(const Unit&, int d) const { return d; }
};

__device__ __forceinline__ unsigned cvt_pk_bf16(float lo, float hi) { unsigned r; asm volatile("v_cvt_pk_bf16_f32 %0, %1, %2" : "=v"(r) : "v"(lo), "v"(hi)); return r; }
typedef float f32x2 __attribute__((ext_vector_type(2)));
__device__ __forceinline__ f32x2 gelu_pk(f32x2 v) {
    const f32x2 av = __builtin_elementwise_abs(v), d = av * 0.2316418882f + 1.0f;
    f32x2 t; t.x = __builtin_amdgcn_rcpf(d.x); t.y = __builtin_amdgcn_rcpf(d.y);
    f32x2 q = t * 0.5307027145f + (-0.7265760135f); q = q * t + 0.7107068705f; q = q * t + (-0.142248368f); q = q * t + 0.127414796f; q = q * t;
    const f32x2 s = (v * v) * (-0.72134752044f);
    f32x2 e; e.x = __builtin_amdgcn_exp2f(s.x); e.y = __builtin_amdgcn_exp2f(s.y);
    const f32x2 m = v * (q * e), r = v - m;
    f32x2 o; o.x = v.x < 0.f ? m.x : r.x; o.y = v.y < 0.f ? m.y : r.y; return o;
}

template <int ACT  > struct EpiBf16 {
    static constexpr bool PERM = true, AFTER_DRAIN = false; static_assert(ACT == 0 || ACT == 1, "EpiBf16: ACT is 0 (none) or 1 (gelu_pk)");
    bf16_t* O; int ldc; const float* bias; int split_cols; size_t split_stride; float scale0;
    __device__ __forceinline__ void operator()(const f32x4 (&acc)[2][2][4][2], const Unit& u, int wr, int wc, int fr, int fq) const {
        const int row0 = u.pm * BM + wr * 64 + fr; int colt = u.pn * BM; bf16_t* base = O;
        float sc = 1.f; if (split_cols) { const int t = colt / split_cols; base += (size_t)t * split_stride; colt -= t * split_cols; if (t == 0) sc = scale0; }
        const int col0 = colt + wc * 32 + 8 * fq, bcol0 = u.pn * BM + wc * 32 + 8 * fq;
        f32x4 bv[2][2];
#pragma unroll
        for (int bj = 0; bj < 2; ++bj)
#pragma unroll
            for (int n = 0; n < 2; ++n) bv[bj][n] = bias ? *(const f32x4*)(bias + bcol0 + bj * HALF + 4 * n) : (f32x4){0.f, 0.f, 0.f, 0.f};
#pragma unroll
        for (int ai = 0; ai < 2; ++ai)
#pragma unroll
            for (int m = 0; m < 4; ++m) { bf16_t* rowp = base + (size_t)(row0 + ai * HALF + m * 16) * ldc + col0;
#pragma unroll
                for (int bj = 0; bj < 2; ++bj) { f32x4 v0 = acc[ai][bj][m][0] + bv[bj][0], v1 = acc[ai][bj][m][1] + bv[bj][1];
                    if (ACT == 1) { f32x2 a = gelu_pk((f32x2){v0[0], v0[1]}), b = gelu_pk((f32x2){v0[2], v0[3]}), c = gelu_pk((f32x2){v1[0], v1[1]}), d = gelu_pk((f32x2){v1[2], v1[3]});
                        v0 = (f32x4){a.x, a.y, b.x, b.y}; v1 = (f32x4){c.x, c.y, d.x, d.y}; }
                    v0 = v0 * sc; v1 = v1 * sc; u32x4 w; w.x = cvt_pk_bf16(v0[0], v0[1]); w.y = cvt_pk_bf16(v0[2], v0[3]); w.z = cvt_pk_bf16(v1[0], v1[1]); w.w = cvt_pk_bf16(v1[2], v1[3]);
                    *(u32x4*)(rowp + bj * HALF) = w; } }
    }
};
template <class Epi, class Sched, bool ALIGN_EPI = false, bool SP2 = false>
__device__ __forceinline__ void gemm_phase(PG8_LAS unsigned char* lds, const Gemm g, const Sched& S, const Epi& E, const int lda) {
    int tid_ = threadIdx.x; const bf16_t* gA = g.A; const bf16_t* gB = g.Bt;
    asm volatile("" : "+v"(tid_), "+s"(gA), "+s"(gB));
    const int tid = tid_, wid = __builtin_amdgcn_readfirstlane(tid >> 6), lane = tid & 63, wr = wid >> 2, wc = wid & 3, fr = lane & 15, fq = lane >> 4;
    const int K = g.K; int nt = K / BK;
    unsigned voffA[2], voffB[2];
#pragma unroll
    for (int i = 0; i < 2; ++i) { int R, C; stage_rc(tid * 16 + i * 8192, R, C); const int Rb = Epi::PERM ? ((R & ~31) + perm32(R & 31)) : R;
        voffA[i] = (unsigned)(R * lda + C) * 2u; voffB[i] = (unsigned)(Rb * K + C) * 2u; }
    const size_t kstep = (size_t)(BK * 2);
    const size_t hstep = (size_t)HALF * K * 2, hstepA = (size_t)HALF * lda * 2;
    const size_t tstep = 2 * hstep, tstepA = 2 * hstepA;
    const unsigned ldsw = (unsigned)wid * 1024u;
    const int aoff = lds_byte(wr * 64 + fr, fq * 8), boff = lds_byte(wc * 32 + fr, fq * 8);
#define PG8_SA(b, h) (((b) * 2 + (h)) * HTB)
#define PG8_SB(b, h) ((4 + (b) * 2 + (h)) * HTB)
#define PG8_STAGE(bufoff, gbase, voff) do { _Pragma("unroll") for (int _i = 0; _i < 2; ++_i) \
        __builtin_amdgcn_global_load_lds((const unsigned*)((const char*)(gbase) + (voff)[_i]), (PG8_LAS unsigned*)(lds + (bufoff) + ldsw + _i * 8192), 16, 0, 0); } while (0)
#define PG8_LDA(dst, b, h) do { _Pragma("unroll") for (int m = 0; m < 4; ++m) _Pragma("unroll") for (int k = 0; k < 2; ++k) dst[m][k] = *(const PG8_LAS bf16x8*)(lds + PG8_SA(b, h) + aoff + m * 2048 + k * 1024); } while (0)
#define PG8_LDB(dst, b, h) do { _Pragma("unroll") for (int n = 0; n < 2; ++n) _Pragma("unroll") for (int k = 0; k < 2; ++k) dst[n][k] = *(const PG8_LAS bf16x8*)(lds + PG8_SB(b, h) + boff + n * 2048 + k * 1024); } while (0)
#define PG8_MMA(ai, bj, At, Bt) do { __builtin_amdgcn_s_setprio(1); _Pragma("unroll") for (int m = 0; m < 4; ++m) _Pragma("unroll") for (int n = 0; n < 2; ++n) _Pragma("unroll") for (int k = 0; k < 2; ++k) \
        acc[ai][bj][m][n] = __builtin_amdgcn_mfma_f32_16x16x32_bf16(Bt[n][k], At[m][k], acc[ai][bj][m][n], 0, 0, 0); __builtin_amdgcn_s_setprio(0); } while (0)
#define PG8_WAIT_V(n) asm volatile("s_waitcnt vmcnt(" #n ")" ::: "memory")
#define PG8_WAIT_L(n) asm volatile("s_waitcnt lgkmcnt(" #n ")" ::: "memory")
#define PG8_BAR __builtin_amdgcn_s_barrier()
#define PG8_SCHED __builtin_amdgcn_sched_barrier(0)
    Unit cur, nxt; int ui = 0;
    if (!S.next(0, cur)) return;
    f32x4 acc[2][2][4][2];
#pragma unroll
    for (int a = 0; a < 2; ++a)
#pragma unroll
        for (int b = 0; b < 2; ++b)
#pragma unroll
            for (int m = 0; m < 4; ++m)
#pragma unroll
                for (int n = 0; n < 2; ++n) acc[a][b][m][n] = (f32x4){0.f, 0.f, 0.f, 0.f};
    bf16x8 At[4][2], B0[2][2], B1[2][2];
    const char* cA = (const char*)gA + (size_t)cur.pm * tstepA + S.aoff(cur); const char* cB = (const char*)gB + (size_t)cur.pn * tstep;
    nt = S.nt(cur, K / BK);
    S.a_ready(cur);
    if constexpr (SP2) {
        PG8_STAGE(PG8_SB(0, 0), cB, voffB); PG8_STAGE(PG8_SB(0, 1), cB + hstep, voffB); PG8_STAGE(PG8_SA(0, 0), cA, voffA); PG8_STAGE(PG8_SA(0, 1), cA + hstepA, voffA);
        if (wr == 1) PG8_BAR;
        PG8_WAIT_V(2); PG8_BAR;
        PG8_STAGE(PG8_SB(1, 0), cB + kstep, voffB); PG8_STAGE(PG8_SA(1, 0), cA + kstep, voffA); PG8_STAGE(PG8_SB(1, 1), cB + hstep + kstep, voffB);
        PG8_WAIT_V(6); PG8_BAR;
    } else {
        PG8_STAGE(PG8_SB(0, 0), cB, voffB); PG8_STAGE(PG8_SA(0, 0), cA, voffA); PG8_STAGE(PG8_SB(0, 1), cB + hstep, voffB); PG8_STAGE(PG8_SA(0, 1), cA + hstepA, voffA);
        if (wr == 1) PG8_BAR;
        PG8_WAIT_V(4); PG8_BAR;
        PG8_STAGE(PG8_SB(1, 0), cB + kstep, voffB); PG8_STAGE(PG8_SA(1, 0), cA + kstep, voffA); PG8_STAGE(PG8_SB(1, 1), cB + hstep + kstep, voffB);
        PG8_WAIT_V(6); PG8_BAR;
    }
    for (;;) {
        const bool has_next = S.next(ui + 1, nxt);
        const char* nA = has_next ? (const char*)gA + (size_t)nxt.pm * tstepA + S.aoff(nxt) : cA; const char* nB = has_next ? (const char*)gB + (size_t)nxt.pn * tstep : cB;
        for (int t = 0; t < nt; t += 2) {
            const bool last = (t == nt - 2);
            const char* a1 = cA + (size_t)(t + 1) * kstep;
            const char* a2 = last ? nA : cA + (size_t)(t + 2) * kstep; const char* b2 = last ? nB : cB + (size_t)(t + 2) * kstep;
            const char* a3 = a2 + kstep; const char* b3 = b2 + kstep;
            if (last && has_next) S.a_ready(nxt);
            if constexpr (SP2) {
            PG8_LDB(B0, 0, 0); PG8_LDB(B1, 0, 1); PG8_SCHED; PG8_LDA(At, 0, 0); PG8_STAGE(PG8_SA(1, 1), a1 + hstepA, voffA);
            PG8_WAIT_V(8); PG8_WAIT_L(0); PG8_BAR; PG8_MMA(0, 0, At, B0); PG8_MMA(0, 1, At, B1); PG8_BAR; PG8_SCHED;
            PG8_LDA(At, 0, 1); PG8_STAGE(PG8_SB(0, 0), b2, voffB); PG8_STAGE(PG8_SB(0, 1), b2 + hstep, voffB); PG8_STAGE(PG8_SA(0, 0), a2, voffA);
            PG8_WAIT_V(8); PG8_WAIT_L(0); PG8_BAR; PG8_MMA(1, 0, At, B0); PG8_MMA(1, 1, At, B1); PG8_BAR; PG8_SCHED;
            PG8_LDB(B0, 1, 0); PG8_LDB(B1, 1, 1); PG8_SCHED; PG8_LDA(At, 1, 0); PG8_STAGE(PG8_SA(0, 1), a2 + hstepA, voffA);
            PG8_WAIT_V(8); PG8_WAIT_L(0); PG8_BAR; PG8_MMA(0, 0, At, B0); PG8_MMA(0, 1, At, B1); PG8_BAR; PG8_SCHED;
            PG8_LDA(At, 1, 1); PG8_STAGE(PG8_SB(1, 0), b3, voffB); PG8_STAGE(PG8_SB(1, 1), b3 + hstep, voffB); PG8_STAGE(PG8_SA(1, 0), a3, voffA);
            PG8_WAIT_V(8); PG8_WAIT_L(0); PG8_BAR; PG8_MMA(1, 0, At, B0); PG8_MMA(1, 1, At, B1); PG8_BAR; PG8_SCHED;
            } else {
            PG8_LDB(B0, 0, 0); PG8_SCHED; PG8_LDA(At, 0, 0); PG8_STAGE(PG8_SA(1, 1), a1 + hstepA, voffA);
            PG8_WAIT_L(8); PG8_BAR; PG8_WAIT_L(0); PG8_MMA(0, 0, At, B0); PG8_BAR; PG8_SCHED;
            PG8_LDB(B1, 0, 1); PG8_STAGE(PG8_SB(0, 0), b2, voffB);
            PG8_BAR; PG8_WAIT_L(0); PG8_MMA(0, 1, At, B1); PG8_BAR;
            PG8_LDA(At, 0, 1); PG8_STAGE(PG8_SA(0, 0), a2, voffA);
            PG8_BAR; PG8_WAIT_L(0); PG8_MMA(1, 0, At, B0); PG8_BAR; PG8_SCHED;
            PG8_STAGE(PG8_SB(0, 1), b2 + hstep, voffB);
            PG8_WAIT_V(6); PG8_BAR; PG8_MMA(1, 1, At, B1); PG8_BAR;
            PG8_LDB(B0, 1, 0); PG8_SCHED; PG8_LDA(At, 1, 0); PG8_STAGE(PG8_SA(0, 1), a2 + hstepA, voffA);
            PG8_WAIT_L(8); PG8_BAR; PG8_WAIT_L(0); PG8_MMA(0, 0, At, B0); PG8_BAR; PG8_SCHED;
            PG8_LDB(B1, 1, 1); PG8_STAGE(PG8_SB(1, 0), b3, voffB);
            PG8_BAR; PG8_WAIT_L(0); PG8_MMA(0, 1, At, B1); PG8_BAR;
            PG8_LDA(At, 1, 1); PG8_STAGE(PG8_SA(1, 0), a3, voffA);
            PG8_BAR; PG8_WAIT_L(0); PG8_MMA(1, 0, At, B0); PG8_BAR; PG8_SCHED;
            PG8_STAGE(PG8_SB(1, 1), b3 + hstep, voffB);
            PG8_WAIT_V(6); PG8_BAR; PG8_MMA(1, 1, At, B1); PG8_BAR;
            }
        }
        if constexpr (ALIGN_EPI) { if (wr == 0) PG8_BAR; }
        if constexpr (!Epi::AFTER_DRAIN) { E(acc, cur, wr, wc, fr, fq); S.done(cur); }
        if (!has_next) break;
#pragma unroll
        for (int a = 0; a < 2; ++a)
#pragma unroll
            for (int b = 0; b < 2; ++b)
#pragma unroll
                for (int m = 0; m < 4; ++m)
#pragma unroll
                    for (int n = 0; n < 2; ++n) acc[a][b][m][n] = (f32x4){0.f, 0.f, 0.f, 0.f};
        cur = nxt; cA = nA; cB = nB; ++ui; nt = S.nt(cur, K / BK);
        if constexpr (ALIGN_EPI) { if (wr == 1) PG8_BAR; }
    }
    PG8_WAIT_V(0);
    if constexpr (!ALIGN_EPI) { if (wr == 0) PG8_BAR; }
    PG8_BAR;
    if constexpr (Epi::AFTER_DRAIN) { E.fused(acc, cur, wr, wc, fr, fq, lds, wid, lane); S.done(cur); }
#undef PG8_SA
#undef PG8_SB
#undef PG8_STAGE
#undef PG8_LDA
#undef PG8_LDB
#undef PG8_MMA
#undef PG8_WAIT_V
#undef PG8_WAIT_L
#undef PG8_BAR
#undef PG8_SCHED
}
}

#define GAS __attribute__((address_space(1)))
#define LAS __attribute__((address_space(3)))
typedef unsigned short bf16;
typedef unsigned v4u __attribute__((ext_vector_type(4)));
typedef unsigned v2u __attribute__((ext_vector_type(2)));
typedef float f32x4 __attribute__((ext_vector_type(4)));
typedef short bf16x8 __attribute__((ext_vector_type(8)));
typedef short s16x4 __attribute__((ext_vector_type(4)));

constexpr int NB = 8, SEQ = 4096, DM = 1024, MTOK = NB * SEQ;
constexpr int ZC = 4864;
constexpr int QA = 0, KA = 768, VA = 1536, XB = 2304, GB = 2816, QC = 3328, KC = 3840, VC = 4352;
constexpr int INC = 7936, FFN = 2816, OC = 1280;
constexpr float NEGF = -1e30f;
constexpr size_t MiB = 1u << 20;
constexpr size_t WS_CTL = 0, CTL_BYTES = 2u << 20;
constexpr size_t WS_KM = 256 * 1024;
constexpr size_t WS_LC = 1 * MiB;
constexpr size_t WS_LF = 1 * MiB + 512 * 1024;
constexpr size_t WS_TABC = 2 * MiB;
constexpr size_t WS_TABA = 2 * MiB + 128 * 1024;
constexpr size_t WS_W = 4 * MiB;
constexpr size_t W_IN = 0, W_PA = W_IN + (size_t)INC * 1024 * 2, W_PB = W_PA + 1024 * 512 * 2, W_PC = W_PB + 1024 * 512 * 2,
                 W_OUT = W_PC + 1024 * 512 * 2, W_GU = W_OUT + 1024 * 1024 * 2, W_DOWN = W_GU + (size_t)5632 * 1024 * 2,
                 W_LA = W_DOWN + (size_t)1024 * 2816 * 2, W_LX = W_LA + 8 * 64 * 64 * 2, W_END = W_LX + 8 * 64 * 64 * 2;
static_assert(W_END <= 40 * MiB, "weights");
constexpr size_t WS_H = 44 * MiB;
constexpr size_t WS_O = 108 * MiB;
constexpr size_t WS_Z = 188 * MiB;
constexpr size_t WS_TMP3 = WS_Z;
constexpr size_t WS_MF = WS_Z + 192 * MiB;
constexpr size_t WS_FFH = WS_Z;
constexpr size_t WS_W2 = 492 * MiB;
constexpr size_t W2_LA = (size_t)INC * 1024 * 2, W2_LX = W2_LA + 8 * 64 * 64 * 2;
static_assert(WS_W2 + W2_LX + 8 * 64 * 64 * 2 <= 508 * MiB, "second W_in copy");
constexpr size_t WS_END = 508 * MiB;
__device__ __forceinline__ unsigned char* win_ptr(unsigned char* ws, int l) { return l == 0 ? ws + WS_W + W_IN : ws + WS_W2; }
__device__ __forceinline__ unsigned char* wla_ptr(unsigned char* ws, int l) { return l == 0 ? ws + WS_W + W_LA : ws + WS_W2 + W2_LA; }
__device__ __forceinline__ unsigned char* wlx_ptr(unsigned char* ws, int l) { return l == 0 ? ws + WS_W + W_LX : ws + WS_W2 + W2_LX; }

constexpr int LDS_BYTES = 163840;
constexpr int PW_IN = 16 * 248, PW_ALL = PW_IN + 4 * 32 + 8 * 32 + 8 * 32 + 16 * 32 + 16 * 176 + 44 * 32, PW_END = PW_ALL + 32;

__device__ __forceinline__ unsigned f2bf(float f) { unsigned u = __builtin_bit_cast(unsigned, f); return (u + 0x7fffu + ((u >> 16) & 1u)) >> 16; }
typedef float f32x2_t __attribute__((ext_vector_type(2))); typedef __bf16 bf16x2_t __attribute__((ext_vector_type(2)));
__device__ __forceinline__ unsigned pk2(float lo, float hi) { f32x2_t v = {lo, hi}; bf16x2_t b = __builtin_convertvector(v, bf16x2_t); return __builtin_bit_cast(unsigned, b); }
__device__ __forceinline__ float bflo(unsigned w) { return __uint_as_float(w << 16); }
__device__ __forceinline__ float bfhi(unsigned w) { return __uint_as_float(w & 0xffff0000u); }
__device__ __forceinline__ float bf2f(bf16 b) { return __uint_as_float((unsigned)b << 16); }
__device__ __forceinline__ float sigmoidf_(float x) { return __builtin_amdgcn_rcpf(1.0f + __expf(-x)); }
__device__ __forceinline__ bf16 f2bf_hw(float x) { return (bf16)(pk2(x, x) & 0xffffu); }
__device__ __forceinline__ float wave_sum(float v) {
#pragma unroll
    for (int o = 1; o < 64; o <<= 1) v += __shfl_xor(v, o);
    return v;
}
__device__ __forceinline__ f32x4 mfma16(bf16x8 a, bf16x8 b, f32x4 c) { return __builtin_amdgcn_mfma_f32_16x16x32_bf16(a, b, c, 0, 0, 0); }
__device__ __forceinline__ s16x4 vtr(const LAS unsigned char* p) { return __builtin_bit_cast(s16x4, __builtin_amdgcn_ds_read_tr16_b64_v4i16((LAS s16x4*)p)); }

#define TO_GLOBAL(T, p) ((T)(GAS void*)(p))
struct Params { const float* in[19]; float* out; unsigned char* ws; };

struct Ctx {
    LAS unsigned char* lds;
    int tid, lane, wave;
    const float* relb;
    unsigned char* ws;
};

__device__ __forceinline__ void transpose_item(const float* W, int K, int N, bf16* WT, int k0, int n0, int drow0, LAS float* scr, int lane, int ldw) {
    { size_t z = 0; asm volatile("" : "+s"(z)); W += z; WT += z; }
    float tw[32];
#pragma unroll
    for (int i = 0; i < 32; ++i) tw[i] = W[(size_t)(k0 + 2 * i + (lane >> 5)) * N + n0 + (lane & 31)];
#pragma unroll
    for (int i = 0; i < 32; ++i) scr[(2 * i + (lane >> 5)) * 33 + (lane & 31)] = tw[i];
    asm volatile("s_waitcnt lgkmcnt(0)" ::: "memory");
    const int c = lane & 7;
#pragma unroll
    for (int j = 0; j < 4; ++j) { const int n = (lane >> 3) + 8 * j; const LAS float* s = scr + (8 * c) * 33 + n;
        v4u o; o.x = pk2(s[0 * 33], s[1 * 33]); o.y = pk2(s[2 * 33], s[3 * 33]); o.z = pk2(s[4 * 33], s[5 * 33]); o.w = pk2(s[6 * 33], s[7 * 33]);
        *(v4u*)(WT + (size_t)(drow0 + n) * ldw + k0 + 8 * c) = o; }
    asm volatile("s_waitcnt lgkmcnt(0)" ::: "memory");
}
__device__ __forceinline__ bool tr_mat(int& r, const float* W, int K, int N, bf16* WT, LAS float* scr, int lane, bool gu, int ldw = 0) {
    const int nkb = K / 64, nnb = N / 32, cnt = nkb * nnb;
    if (r >= cnt) { r -= cnt; return false; }
    const int kb = r / nnb, nb = r % nnb, n0 = nb * 32;
    int drow = n0;
    if (gu) { drow = (n0 < FFN) ? (n0 / 128) * 256 + (n0 % 128) : ((n0 - FFN) / 128) * 256 + 128 + ((n0 - FFN) % 128); }
    transpose_item(W, K, N, WT, kb * 64, n0, drow, scr, lane, ldw ? ldw : K);
    return true;
}
template <int NR>
__device__ __forceinline__ void rms_rows_bf16(const float* x, const float* g, bf16* o, int m0, int mstride, int lane) {
    { size_t z = 0; asm volatile("" : "+s"(z)); g += z; }
    const f32x4* gr = (const f32x4*)g + lane;
    f32x4 v[NR][4];
#pragma unroll
    for (int k = 0; k < NR; ++k) { const f32x4* xr = (const f32x4*)(x + (size_t)(m0 + k * mstride) * DM) + lane;
#pragma unroll
        for (int j = 0; j < 4; ++j) v[k][j] = xr[64 * j]; }
    f32x4 gg[4];
#pragma unroll
    for (int j = 0; j < 4; ++j) gg[j] = gr[64 * j];
#pragma unroll
    for (int k = 0; k < NR; ++k) { float s = 0.f;
#pragma unroll
        for (int j = 0; j < 4; ++j) s += (v[k][j].x * v[k][j].x + v[k][j].y * v[k][j].y) + (v[k][j].z * v[k][j].z + v[k][j].w * v[k][j].w);
        const float rs = __builtin_amdgcn_rsqf(wave_sum(s) * (1.f / DM) + 1e-6f);
        v2u* o8 = (v2u*)(o + (size_t)(m0 + k * mstride) * DM) + lane;
#pragma unroll
        for (int j = 0; j < 4; ++j) { v2u w; w.x = pk2(v[k][j].x * rs * gg[j].x, v[k][j].y * rs * gg[j].y); w.y = pk2(v[k][j].z * rs * gg[j].z, v[k][j].w * rs * gg[j].w); o8[64 * j] = w; } }
}
template <int NR>
__device__ __forceinline__ void rms_rows_f32(float* x, const float* g, int m0, int mstride, int lane) {
    { size_t z = 0; asm volatile("" : "+s"(z)); g += z; }
    const f32x4* gr = (const f32x4*)g + lane;
    f32x4 v[NR][4];
#pragma unroll
    for (int k = 0; k < NR; ++k) { const f32x4* xr = (const f32x4*)(x + (size_t)(m0 + k * mstride) * DM) + lane;
#pragma unroll
        for (int j = 0; j < 4; ++j) v[k][j] = xr[64 * j]; }
    f32x4 gg[4];
#pragma unroll
    for (int j = 0; j < 4; ++j) gg[j] = gr[64 * j];
#pragma unroll
    for (int k = 0; k < NR; ++k) { float s = 0.f;
#pragma unroll
        for (int j = 0; j < 4; ++j) s += (v[k][j].x * v[k][j].x + v[k][j].y * v[k][j].y) + (v[k][j].z * v[k][j].z + v[k][j].w * v[k][j].w);
        const float rs = __builtin_amdgcn_rsqf(wave_sum(s) * (1.f / DM) + 1e-6f);
        f32x4* xr = (f32x4*)(x + (size_t)(m0 + k * mstride) * DM) + lane;
#pragma unroll
        for (int j = 0; j < 4; ++j) xr[64 * j] = v[k][j] * rs * gg[j]; }
}
__device__ __forceinline__ int rel_bucket_dev(int d) {
    if (d < 16) return d;
    const float df = (float)d;
    int large = 16 + (int)(logf(df / 16.0f) / 4.852030263919617f * 16.0f);
    return large < 31 ? large : 31;
}

__device__ __forceinline__ void prep_weights(const Ctx& C, const Params& p, int l, int gw, int NGW, int lo, int hi) {
    LAS float* scr = (LAS float*)(C.lds + C.wave * 16384);
    unsigned char* wb = C.ws + WS_W;
    for (int it = lo + gw; it < hi; it += NGW) {
        int r = it;
        if (tr_mat(r, p.in[3] + (size_t)l * 1024 * INC, 1024, INC, (bf16*)win_ptr(C.ws, l), scr, C.lane, false)) continue;
        if (tr_mat(r, p.in[11] + (size_t)l * 256 * 1024, 256, 1024, (bf16*)(wb + W_PA), scr, C.lane, false, 512)) continue;
        if (tr_mat(r, p.in[12] + (size_t)l * 512 * 1024, 512, 1024, (bf16*)(wb + W_PB), scr, C.lane, false)) continue;
        if (tr_mat(r, p.in[13] + (size_t)l * 512 * 1024, 512, 1024, (bf16*)(wb + W_PC), scr, C.lane, false)) continue;
        if (tr_mat(r, p.in[14] + (size_t)l * 1024 * 1024, 1024, 1024, (bf16*)(wb + W_OUT), scr, C.lane, false)) continue;
        if (tr_mat(r, p.in[16] + (size_t)l * 1024 * 5632, 1024, 5632, (bf16*)(wb + W_GU), scr, C.lane, true)) continue;
        if (tr_mat(r, p.in[17] + (size_t)l * 2816 * 1024, 2816, 1024, (bf16*)(wb + W_DOWN), scr, C.lane, false)) continue;
        { const int which = r / 16, rr = r % 16, mat = rr / 2, nb = rr % 2;
          const float* W = p.in[which ? 8 : 6] + (size_t)l * 8 * 4096 + mat * 4096;
          bf16* WT = (bf16*)(which ? wlx_ptr(C.ws, l) : wla_ptr(C.ws, l)) + mat * 4096;
          transpose_item(W, 64, 64, WT, 0, nb * 32, nb * 32, scr, C.lane, 64); }
    }
}

using pg8::Unit;
using pg8::cvt_pk_bf16;
struct EpiZ {
    static constexpr bool PERM = true, AFTER_DRAIN = false;
    bf16* O; float* KM;
    __device__ __forceinline__ void operator()(const f32x4 (&acc)[2][2][4][2], const Unit& u, int wr, int wc, int fr, int fq) const {
        const int row0 = u.pm * 256 + wr * 64 + fr, col0 = u.pn * 256 + wc * 32 + 8 * fq;
#pragma unroll
        for (int ai = 0; ai < 2; ++ai)
#pragma unroll
            for (int m = 0; m < 4; ++m) { bf16* rowp = O + (size_t)(row0 + ai * 128 + m * 16) * ZC + col0;
#pragma unroll
                for (int bj = 0; bj < 2; ++bj) { const f32x4 v0 = acc[ai][bj][m][0], v1 = acc[ai][bj][m][1]; v4u w;
                    w.x = cvt_pk_bf16(v0[0], v0[1]); w.y = cvt_pk_bf16(v0[2], v0[3]); w.z = cvt_pk_bf16(v1[0], v1[1]); w.w = cvt_pk_bf16(v1[2], v1[3]);
                    *(v4u*)(rowp + bj * 128) = w; } }
        if (u.pn == 15 || u.pn == 16) {
#pragma unroll
            for (int bj = 0; bj < 2; ++bj)
#pragma unroll
                for (int n = 0; n < 2; ++n) {
                    f32x4 s = (f32x4){0.f, 0.f, 0.f, 0.f};
#pragma unroll
                    for (int ai = 0; ai < 2; ++ai)
#pragma unroll
                        for (int m = 0; m < 4; ++m) s += acc[ai][bj][m][n];
#pragma unroll
                    for (int j = 0; j < 4; ++j) { float t = s[j]; t += __shfl_xor(t, 1); t += __shfl_xor(t, 2); t += __shfl_xor(t, 4); t += __shfl_xor(t, 8); s[j] = t; }
                    if (fr == 0) { float* d = KM + (size_t)u.pm * 512 + (col0 - KC) + bj * 128 + 4 * n;
#pragma unroll
                        for (int j = 0; j < 4; ++j) atomicAdd(d + j, s[j]); }
                }
        }
    }
};
struct EpiResid {
    static constexpr bool PERM = true, AFTER_DRAIN = false;
    const float* base; float* out;
    __device__ __forceinline__ void operator()(const f32x4 (&acc)[2][2][4][2], const Unit& u, int wr, int wc, int fr, int fq) const {
        const int row0 = u.pm * 256 + wr * 64 + fr, col0 = u.pn * 256 + wc * 32 + 8 * fq;
#pragma unroll
        for (int ai = 0; ai < 2; ++ai) {
            f32x4 bv[4][2][2];
#pragma unroll
            for (int m = 0; m < 4; ++m)
#pragma unroll
                for (int bj = 0; bj < 2; ++bj) { const float* bp = base + (size_t)(row0 + ai * 128 + m * 16) * DM + col0 + bj * 128; bv[m][bj][0] = *(const f32x4*)bp; bv[m][bj][1] = *(const f32x4*)(bp + 4); }
            asm volatile("" ::: "memory");
#pragma unroll
            for (int m = 0; m < 4; ++m)
#pragma unroll
                for (int bj = 0; bj < 2; ++bj) { float* op = out + (size_t)(row0 + ai * 128 + m * 16) * DM + col0 + bj * 128;
                    *(f32x4*)op = bv[m][bj][0] + acc[ai][bj][m][0]; *(f32x4*)(op + 4) = bv[m][bj][1] + acc[ai][bj][m][1]; }
            asm volatile("" ::: "memory");
        }
    }
};
struct EpiSwiGLU {
    static constexpr bool PERM = true, AFTER_DRAIN = false;
    bf16* O;
    __device__ __forceinline__ void operator()(const f32x4 (&acc)[2][2][4][2], const Unit& u, int wr, int wc, int fr, int fq) const {
        const int row0 = u.pm * 256 + wr * 64 + fr, col0 = u.pn * 128 + wc * 32 + 8 * fq;
#pragma unroll
        for (int ai = 0; ai < 2; ++ai)
#pragma unroll
            for (int m = 0; m < 4; ++m) { bf16* rowp = O + (size_t)(row0 + ai * 128 + m * 16) * FFN + col0;
                float r[8];
#pragma unroll
                for (int n = 0; n < 2; ++n)
#pragma unroll
                    for (int j = 0; j < 4; ++j) { const float g = acc[ai][0][m][n][j], up = acc[ai][1][m][n][j]; r[4 * n + j] = g * sigmoidf_(g) * up; }
                v4u w; w.x = cvt_pk_bf16(r[0], r[1]); w.y = cvt_pk_bf16(r[2], r[3]); w.z = cvt_pk_bf16(r[4], r[5]); w.w = cvt_pk_bf16(r[6], r[7]);
                *(v4u*)rowp = w; }
    }
};

struct GateOrder {
    pg8::StaticOrder T;
    __device__ void init(int G, int c) { T.init(MTOK, DM, G, c); }
    __device__ bool next(int i, Unit& u) const { Unit t; if (!T.next(i / 3, t)) return false; u.pm = t.pm; u.pn = (i % 3) * 4 + t.pn; return true; }
    __device__ __forceinline__ void a_ready(const Unit&) const {}
    __device__ __forceinline__ void done(const Unit&) const {}
    __device__ __forceinline__ size_t aoff(const Unit&) const { return 0; }
    __device__ __forceinline__ int nt(const Unit&, int d) const { return d; }
};
struct ProdOrder : GateOrder {
    __device__ __forceinline__ size_t aoff(const Unit& u) const { const int br = u.pn >> 2; return (size_t)(br == 0 ? 0 : (br == 1 ? 256 : 768)) * 2; }
    __device__ __forceinline__ int nt(const Unit& u, int) const { return (u.pn >> 2) == 0 ? 4 : 8; }
};
struct EpiTmp3 {
    static constexpr bool PERM = true, AFTER_DRAIN = false;
    bf16* O;
    __device__ __forceinline__ void operator()(const f32x4 (&acc)[2][2][4][2], const Unit& u, int wr, int wc, int fr, int fq) const {
        const int row0 = u.pm * 256 + wr * 64 + fr, col0 = u.pn * 256 + wc * 32 + 8 * fq;
#pragma unroll
        for (int ai = 0; ai < 2; ++ai)
#pragma unroll
            for (int m = 0; m < 4; ++m) { bf16* rowp = O + (size_t)(row0 + ai * 128 + m * 16) * 3072 + col0;
#pragma unroll
                for (int bj = 0; bj < 2; ++bj) { const f32x4 v0 = acc[ai][bj][m][0], v1 = acc[ai][bj][m][1]; v4u w;
                    w.x = cvt_pk_bf16(v0[0], v0[1]); w.y = cvt_pk_bf16(v0[2], v0[3]); w.z = cvt_pk_bf16(v1[0], v1[1]); w.w = cvt_pk_bf16(v1[2], v1[3]);
                    *(v4u*)(rowp + bj * 128) = w; } }
    }
};
struct EpiGate3 {
    static constexpr bool PERM = true, AFTER_DRAIN = false;
    bf16* T3;
    __device__ __forceinline__ void operator()(const f32x4 (&acc)[2][2][4][2], const Unit& u, int wr, int wc, int fr, int fq) const {
        const int br = u.pn >> 2, cn = u.pn & 3;
        const int row0 = u.pm * 256 + wr * 64 + fr, colm = cn * 256 + wc * 32 + 8 * fq, colt = u.pn * 256 + wc * 32 + 8 * fq;
#pragma unroll
        for (int ai = 0; ai < 2; ++ai) {
            v4u tv[4][2], av[4][2];
#pragma unroll
            for (int m = 0; m < 4; ++m)
#pragma unroll
                for (int bj = 0; bj < 2; ++bj) { const bf16* rp = T3 + (size_t)(row0 + ai * 128 + m * 16) * 3072 + bj * 128;
                    tv[m][bj] = *(const v4u*)(rp + colt); av[m][bj] = (br != 0) ? *(const v4u*)(rp + colm) : (v4u){0u, 0u, 0u, 0u}; }
            asm volatile("" ::: "memory");
#pragma unroll
            for (int m = 0; m < 4; ++m)
#pragma unroll
                for (int bj = 0; bj < 2; ++bj) { const f32x4 a0 = acc[ai][bj][m][0], a1 = acc[ai][bj][m][1]; const v4u t = tv[m][bj], o = av[m][bj];
                    v4u w;
                    w.x = cvt_pk_bf16(bflo(o.x) + sigmoidf_(a0[0]) * bflo(t.x), bfhi(o.x) + sigmoidf_(a0[1]) * bfhi(t.x));
                    w.y = cvt_pk_bf16(bflo(o.y) + sigmoidf_(a0[2]) * bflo(t.y), bfhi(o.y) + sigmoidf_(a0[3]) * bfhi(t.y));
                    w.z = cvt_pk_bf16(bflo(o.z) + sigmoidf_(a1[0]) * bflo(t.z), bfhi(o.z) + sigmoidf_(a1[1]) * bfhi(t.z));
                    w.w = cvt_pk_bf16(bflo(o.w) + sigmoidf_(a1[2]) * bflo(t.w), bfhi(o.w) + sigmoidf_(a1[3]) * bfhi(t.w));
                    *(v4u*)(T3 + (size_t)(row0 + ai * 128 + m * 16) * 3072 + bj * 128 + colm) = w; }
            asm volatile("" ::: "memory");
        }
    }
};

constexpr int AT_TAB = 0, AT_VST = 2176, AT_OG = 40960, AT_LSE = 40960 + 98304;
__device__ __forceinline__ void attnA_unit(const Ctx& C, int unit) {
#define SBAR() __builtin_amdgcn_sched_barrier(0)
    const int b = unit >> 6, j = (unit >> 4) & 3, T0 = (unit & 15) * 256;
    const GAS unsigned char* Zg = (const GAS unsigned char*)(C.ws + WS_Z) + (size_t)b * SEQ * ZC * 2;
    LAS float* biasT = (LAS float*)(C.lds + AT_TAB);
    LAS unsigned char* Vst = C.lds + AT_VST + C.wave * 4608;
    LAS bf16* OG = (LAS bf16*)(C.lds + AT_OG);
    LAS float* LSEl = (LAS float*)(C.lds + AT_LSE);
    const int lane = C.lane, i16 = lane & 15, g = lane >> 4;
    { const GAS float* TA = (const GAS float*)(C.ws + WS_TABA);
      for (int idx = C.tid; idx < 3 * 176; idx += 512) { const int grp = idx / 176, e = idx % 176 - 16; biasT[idx] = (e >= 0 && e <= 128) ? TA[(grp * 4 + j) * 132 + e] : 0.f; } }
    __syncthreads();
    const int L = i16 + 144 - 8 * g;
#pragma unroll 1
    for (int it = C.wave; it < 48; it += 8) {
        const int grp = it >> 4, k = it & 15;
        int dl, r, i0;
        if (grp == 0) { dl = 1; r = 0; i0 = T0 + 16 * k; } else if (grp == 1) { dl = 4; r = k & 3; i0 = (T0 >> 2) + 16 * (k >> 2); } else { dl = 16; r = k; i0 = T0 >> 4; }
        const int head = 4 * grp + j;
        const unsigned rstride = (unsigned)dl * (ZC * 2), rbase = (unsigned)r * (ZC * 2);
        const int tq = r + dl * (i0 + i16);
        const unsigned qoff = (unsigned)tq * (ZC * 2) + (QA + head * 64 + 8 * g) * 2;
        const bf16x8 q0 = *(const GAS bf16x8*)(Zg + qoff), q1 = *(const GAS bf16x8*)(Zg + qoff + 64);
        const int kbase = i0 - 144;
        const int klane = kbase + 8 * (i16 >> 2) + (i16 & 3);
        const unsigned kcol = rbase + (KA + head * 64 + 8 * g) * 2;
        bf16x8 kf[10][2];
#pragma unroll
        for (int kt = 0; kt < 10; ++kt) { int ks = klane + 32 * (kt >> 1) + 4 * (kt & 1); ks = ks < 0 ? 0 : ks;
            const unsigned off = (unsigned)ks * rstride + kcol; kf[kt][0] = *(const GAS bf16x8*)(Zg + off); kf[kt][1] = *(const GAS bf16x8*)(Zg + off + 64); }
        v4u vreg[5][4];
        { const int vl = kbase + (lane >> 3); const unsigned vcol = rbase + (VA + head * 64 + (lane & 7) * 8) * 2;
#pragma unroll
          for (int s5 = 0; s5 < 5; ++s5)
#pragma unroll
            for (int i = 0; i < 4; ++i) { int ks = vl + 32 * s5 + 8 * i; ks = ks < 0 ? 0 : ks; vreg[s5][i] = *(const GAS v4u*)(Zg + (unsigned)ks * rstride + vcol); } }
        SBAR();
        f32x4 S[10];
#pragma unroll
        for (int kt = 0; kt < 10; ++kt) { f32x4 a = mfma16(kf[kt][0], q0, (f32x4){0.f, 0.f, 0.f, 0.f}); S[kt] = mfma16(kf[kt][1], q1, a); }
        const LAS float* tb = biasT + grp * 176 + 16 + L - 159;
        const int kneg = kbase + 8 * g;
        const bool anyneg = kbase < 0;
        float tv[40];
#pragma unroll
        for (int kt = 0; kt < 10; ++kt)
#pragma unroll
            for (int jj = 0; jj < 4; ++jj) tv[4 * kt + jj] = tb[159 - (32 * (kt >> 1) + 4 * (kt & 1) + jj)];
        SBAR();
        float mx = NEGF;
#pragma unroll
        for (int kt = 0; kt < 10; ++kt)
#pragma unroll
            for (int jj = 0; jj < 4; ++jj) {
                const int c = 32 * (kt >> 1) + 4 * (kt & 1) + jj;
                float v = S[kt][jj] * 0.125f + tv[4 * kt + jj];
                if ((kt >> 1) == 0) v = (L - c <= 128) ? v : NEGF;
                if ((kt >> 1) == 4) v = (L - c >= 0) ? v : NEGF;
                S[kt][jj] = v;
            }
        if (anyneg) {
#pragma unroll
            for (int kt = 0; kt < 10; ++kt)
#pragma unroll
                for (int jj = 0; jj < 4; ++jj) { const int c = 32 * (kt >> 1) + 4 * (kt & 1) + jj; S[kt][jj] = (kneg + c >= 0) ? S[kt][jj] : NEGF; }
        }
#pragma unroll
        for (int kt = 0; kt < 10; ++kt)
#pragma unroll
            for (int jj = 0; jj < 4; ++jj) mx = fmaxf(mx, S[kt][jj]);
        mx = fmaxf(mx, __shfl_xor(mx, 16)); mx = fmaxf(mx, __shfl_xor(mx, 32));
        float sum = 0.f; const float mxl = mx * 1.4426950408889634f;
#pragma unroll
        for (int kt = 0; kt < 10; ++kt)
#pragma unroll
            for (int jj = 0; jj < 4; ++jj) { const float pv = __builtin_amdgcn_exp2f(S[kt][jj] * 1.4426950408889634f - mxl); S[kt][jj] = pv; sum += pv; }
        sum += __shfl_xor(sum, 16); sum += __shfl_xor(sum, 32);
        f32x4 O[4];
#pragma unroll
        for (int c = 0; c < 4; ++c) O[c] = (f32x4){0.f, 0.f, 0.f, 0.f};
        const LAS unsigned char* vrd = Vst + (8 * g + (i16 >> 2)) * 144 + 8 * (i16 & 3);
        LAS unsigned char* vwr = Vst + (lane >> 3) * 144 + (lane & 7) * 16;
#pragma unroll
        for (int s5 = 0; s5 < 5; ++s5) {
#pragma unroll
            for (int i = 0; i < 4; ++i) *(LAS v4u*)(vwr + 8 * i * 144) = vreg[s5][i];
            v4u pw; pw.x = pk2(S[2 * s5][0], S[2 * s5][1]); pw.y = pk2(S[2 * s5][2], S[2 * s5][3]); pw.z = pk2(S[2 * s5 + 1][0], S[2 * s5 + 1][1]); pw.w = pk2(S[2 * s5 + 1][2], S[2 * s5 + 1][3]);
            const bf16x8 pb = __builtin_bit_cast(bf16x8, pw);
            s16x4 vl[4][2];
#pragma unroll
            for (int c = 0; c < 4; ++c) { vl[c][0] = vtr(vrd + 32 * c); vl[c][1] = vtr(vrd + 32 * c + 4 * 144); }
            SBAR();
#pragma unroll
            for (int c = 0; c < 4; ++c) { const s16x4 lo = vl[c][0], hi = vl[c][1];
                const bf16x8 vf = (bf16x8){lo[0], lo[1], lo[2], lo[3], hi[0], hi[1], hi[2], hi[3]};
                O[c] = mfma16(vf, pb, O[c]); }
            SBAR();
        }
        const float inv = __builtin_amdgcn_rcpf(sum);
        LAS bf16* op = OG + (grp * 256 + (tq - T0)) * 64 + 4 * g;
#pragma unroll
        for (int c = 0; c < 4; ++c) { v2u w; w.x = pk2(O[c][0] * inv, O[c][1] * inv); w.y = pk2(O[c][2] * inv, O[c][3] * inv); *(LAS v2u*)(op + 16 * c) = w; }
        if (g == 0) LSEl[grp * 256 + (tq - T0)] = mx + __logf(sum);
    }
    __syncthreads();
    GAS bf16* Ob = (GAS bf16*)(C.ws + WS_O) + (size_t)b * SEQ * OC;
    for (int w = C.tid; w < 256 * 8; w += 512) {
        const int tl = w >> 3, tok = T0 + tl, ch = w & 7;
        const float l0 = LSEl[tl], l1 = LSEl[256 + tl], l2 = LSEl[512 + tl];
        const float mm = fmaxf(l0, fmaxf(l1, l2));
        float w0 = __expf(l0 - mm), w1 = __expf(l1 - mm), w2 = __expf(l2 - mm); const float iv = __builtin_amdgcn_rcpf(w0 + w1 + w2); w0 *= iv; w1 *= iv; w2 *= iv;
        const LAS bf16* zr = OG + tl * 64 + ch * 8;
        const v4u a = *(const LAS v4u*)zr, bq = *(const LAS v4u*)(zr + 256 * 64), c = *(const LAS v4u*)(zr + 512 * 64);
        v4u o;
        o.x = pk2(w0 * bflo(a.x) + w1 * bflo(bq.x) + w2 * bflo(c.x), w0 * bfhi(a.x) + w1 * bfhi(bq.x) + w2 * bfhi(c.x));
        o.y = pk2(w0 * bflo(a.y) + w1 * bflo(bq.y) + w2 * bflo(c.y), w0 * bfhi(a.y) + w1 * bfhi(bq.y) + w2 * bfhi(c.y));
        o.z = pk2(w0 * bflo(a.z) + w1 * bflo(bq.z) + w2 * bflo(c.z), w0 * bfhi(a.z) + w1 * bfhi(bq.z) + w2 * bfhi(c.z));
        o.w = pk2(w0 * bflo(a.w) + w1 * bflo(bq.w) + w2 * bflo(c.w), w0 * bfhi(a.w) + w1 * bfhi(bq.w) + w2 * bfhi(c.w));
        *(GAS v4u*)(Ob + (size_t)tok * OC + j * 64 + ch * 8) = o;
    }
    __syncthreads();
#undef SBAR
}

constexpr int MB_CNT = 64, MB_M = 1024, MB_L = 2048, MB_LIST = 3072, MB_TAB = 8192, MB_OST = 24576, MB_K = 90112, MB_V = 126976;
template <bool OWN>
__device__ __forceinline__ void moba_item(const bf16x8 q0, const bf16x8 q1, LAS unsigned char* lds, int lane, int qb, int n, int qid, bool valid, int smax) {
#define SBAR() __builtin_amdgcn_sched_barrier(0)
    const int i16 = lane & 15, g = lane >> 4;
    LAS float* Ost = (LAS float*)(lds + MB_OST); LAS float* mst = (LAS float*)(lds + MB_M); LAS float* lst = (LAS float*)(lds + MB_L);
    const LAS unsigned char* kbase = lds + MB_K + (8 * (i16 >> 2) + (i16 & 3)) * 144 + 16 * g;
    const LAS unsigned char* vbase = lds + MB_V + (8 * g + (i16 >> 2)) * 144 + 8 * (i16 & 3);
    f32x4 S[16];
#pragma unroll
    for (int sp = 0; sp < 4; ++sp) if (!OWN || 2 * sp <= smax) {
        bf16x8 kf[4][2];
#pragma unroll
        for (int t = 0; t < 4; ++t) { const LAS unsigned char* kp = kbase + (64 * sp + 32 * (t >> 1) + 4 * (t & 1)) * 144; kf[t][0] = *(const LAS bf16x8*)kp; kf[t][1] = *(const LAS bf16x8*)(kp + 64); }
        SBAR();
#pragma unroll
        for (int t = 0; t < 4; ++t) { f32x4 a = mfma16(kf[t][0], q0, (f32x4){0.f, 0.f, 0.f, 0.f}); S[4 * sp + t] = mfma16(kf[t][1], q1, a); }
        SBAR();
    }
    const float c2 = 0.125f * 1.4426950408889634f;
    const LAS float* tb = (const LAS float*)(lds + MB_TAB) + (256 * (qb - n) + qid - 8 * g - 255);
    float mx = NEGF;
#pragma unroll
    for (int sp = 0; sp < 4; ++sp) if (!OWN || 2 * sp <= smax) {
        float tv[16];
#pragma unroll
        for (int t = 0; t < 4; ++t)
#pragma unroll
            for (int jj = 0; jj < 4; ++jj) tv[4 * t + jj] = tb[255 - (64 * sp + 32 * (t >> 1) + 4 * (t & 1) + jj)];
        SBAR();
#pragma unroll
        for (int t = 0; t < 4; ++t)
#pragma unroll
            for (int jj = 0; jj < 4; ++jj) {
                float v = S[4 * sp + t][jj] * c2 + tv[4 * t + jj];
                if (OWN) { const int key = 64 * sp + 32 * (t >> 1) + 8 * g + 4 * (t & 1) + jj; v = (key <= qid) ? v : NEGF; }
                S[4 * sp + t][jj] = v; mx = fmaxf(mx, v);
            }
    }
    mx = fmaxf(mx, __shfl_xor(mx, 16)); mx = fmaxf(mx, __shfl_xor(mx, 32));
    float sum = 0.f;
#pragma unroll
    for (int sp = 0; sp < 4; ++sp) if (!OWN || 2 * sp <= smax) {
#pragma unroll
        for (int t = 0; t < 4; ++t)
#pragma unroll
            for (int jj = 0; jj < 4; ++jj) { const float pv = __builtin_amdgcn_exp2f(S[4 * sp + t][jj] - mx); S[4 * sp + t][jj] = pv; sum += pv; }
    }
    sum += __shfl_xor(sum, 16); sum += __shfl_xor(sum, 32);
    f32x4 O[4];
#pragma unroll
    for (int c = 0; c < 4; ++c) O[c] = (f32x4){0.f, 0.f, 0.f, 0.f};
#pragma unroll
    for (int s8 = 0; s8 < 8; ++s8) if (!OWN || (s8 >> 1) * 2 <= smax) {
        s16x4 vl[4][2];
#pragma unroll
        for (int c = 0; c < 4; ++c) { const LAS unsigned char* vp = vbase + (32 * s8) * 144 + 32 * c; vl[c][0] = vtr(vp); vl[c][1] = vtr(vp + 4 * 144); }
        const int t0 = 2 * s8; v4u pw; pw.x = pk2(S[t0][0], S[t0][1]); pw.y = pk2(S[t0][2], S[t0][3]); pw.z = pk2(S[t0 + 1][0], S[t0 + 1][1]); pw.w = pk2(S[t0 + 1][2], S[t0 + 1][3]);
        const bf16x8 pb = __builtin_bit_cast(bf16x8, pw);
        SBAR();
#pragma unroll
        for (int c = 0; c < 4; ++c) { const s16x4 lo = vl[c][0], hi = vl[c][1];
            const bf16x8 vf = (bf16x8){lo[0], lo[1], lo[2], lo[3], hi[0], hi[1], hi[2], hi[3]};
            O[c] = mfma16(vf, pb, O[c]); }
        SBAR();
    }
    if (valid) {
        LAS float* orow = Ost + qid * 64;
        if (OWN) {
#pragma unroll
            for (int c = 0; c < 4; ++c) *(LAS f32x4*)(orow + 4 * ((4 * c + g) ^ (qid & 15))) = O[c];
            if (g == 0) { mst[qid] = mx; lst[qid] = sum; }
        } else {
            const float mo = mst[qid], lo_ = lst[qid];
            f32x4 old[4];
#pragma unroll
            for (int c = 0; c < 4; ++c) old[c] = *(LAS f32x4*)(orow + 4 * ((4 * c + g) ^ (qid & 15)));
            const float mn = fmaxf(mo, mx), ao = __builtin_amdgcn_exp2f(mo - mn), ap = __builtin_amdgcn_exp2f(mx - mn);
#pragma unroll
            for (int c = 0; c < 4; ++c) *(LAS f32x4*)(orow + 4 * ((4 * c + g) ^ (qid & 15))) = old[c] * ao + O[c] * ap;
            if (g == 0) { mst[qid] = mn; lst[qid] = lo_ * ao + sum * ap; }
        }
    }
#undef SBAR
}
__device__ __forceinline__ void moba_unit(const Ctx& C, int unit, const float* KM) {
    const int qb = 15 - (unit >> 6), bh = unit & 63, b = bh >> 3, h = bh & 7;
    const bf16* Zb = (const bf16*)(C.ws + WS_Z) + (size_t)b * SEQ * ZC;
    LAS unsigned char* lds = C.lds - 64;
    LAS int* cnt = (LAS int*)(lds + MB_CNT);
    LAS unsigned char* lists = lds + MB_LIST;
    LAS float* tabC = (LAS float*)(lds + MB_TAB);
    LAS float* kml = (LAS float*)(lds + MB_K);
    const int lane = C.lane, i16 = lane & 15, tid = C.tid;
    const int ndist = 256 * qb + 256;
    {
        const float* TC = (const float*)(C.ws + WS_TABC) + h * 4096;
        float tv[8], kv[2]; v4u qv[8];
#pragma unroll
        for (int i = 0; i < 8; ++i) { const int d = tid + 512 * i; tv[i] = (d < ndist) ? TC[d] : 0.f; }
#pragma unroll
        for (int i = 0; i < 2; ++i) { const int e = tid + 512 * i; kv[i] = (e < qb * 64) ? KM[(size_t)(b * 16 + (e >> 6)) * 512 + h * 64 + (e & 63)] : 0.f; }
        if (tid < 256) { const bf16* qp = Zb + (size_t)(qb * 256 + tid) * ZC + QC + h * 64;
#pragma unroll
            for (int c = 0; c < 8; ++c) qv[c] = *(const v4u*)(qp + 8 * c); }
#pragma unroll
        for (int i = 0; i < 8; ++i) { const int d = tid + 512 * i; if (d < ndist) tabC[d] = tv[i]; }
#pragma unroll
        for (int i = 0; i < 2; ++i) { const int e = tid + 512 * i; if (e < qb * 64) kml[e] = kv[i] * (1.0f / 256.0f); }
        if (tid < 16) cnt[tid] = 0;
        __syncthreads();
        if (tid < 256) {
        float qf[64];
#pragma unroll
        for (int c = 0; c < 8; ++c) { const v4u w = qv[c];
            qf[8 * c + 0] = bflo(w.x); qf[8 * c + 1] = bfhi(w.x); qf[8 * c + 2] = bflo(w.y); qf[8 * c + 3] = bfhi(w.y);
            qf[8 * c + 4] = bflo(w.z); qf[8 * c + 5] = bfhi(w.z); qf[8 * c + 6] = bflo(w.w); qf[8 * c + 7] = bfhi(w.w); }
        float v1 = -3e38f, v2 = -3e38f, v3 = -3e38f; int i1 = -1, i2 = -1, i3 = -1;
        for (int n = 0; n < qb; ++n) {
            float s = 0.f;
#pragma unroll
            for (int e4 = 0; e4 < 16; ++e4) { const f32x4 kv = *(const LAS f32x4*)(kml + n * 64 + 4 * e4);
                s += qf[4 * e4] * kv[0]; s += qf[4 * e4 + 1] * kv[1]; s += qf[4 * e4 + 2] * kv[2]; s += qf[4 * e4 + 3] * kv[3]; }
            if (s > v1) { v3 = v2; i3 = i2; v2 = v1; i2 = i1; v1 = s; i1 = n; }
            else if (s > v2) { v3 = v2; i3 = i2; v2 = s; i2 = n; }
            else if (s > v3) { v3 = s; i3 = n; }
        }
        if (i1 >= 0) { const int pos = __hip_atomic_fetch_add(cnt + i1, 1, __ATOMIC_RELAXED, __HIP_MEMORY_SCOPE_WORKGROUP); lists[i1 * 256 + pos] = (unsigned char)tid; }
        if (i2 >= 0) { const int pos = __hip_atomic_fetch_add(cnt + i2, 1, __ATOMIC_RELAXED, __HIP_MEMORY_SCOPE_WORKGROUP); lists[i2 * 256 + pos] = (unsigned char)tid; }
        if (i3 >= 0) { const int pos = __hip_atomic_fetch_add(cnt + i3, 1, __ATOMIC_RELAXED, __HIP_MEMORY_SCOPE_WORKGROUP); lists[i3 * 256 + pos] = (unsigned char)tid; }
        }
    }
    v4u kreg[4], vreg[4];
#define MB_LOAD(nn) do { _Pragma("unroll") for (int i = 0; i < 4; ++i) { const int cidx = tid + 512 * i, row = cidx >> 3, ch = cidx & 7; \
        const bf16* src = Zb + (size_t)((nn) * 256 + row) * ZC + h * 64 + ch * 8; kreg[i] = *(const v4u*)(src + KC); vreg[i] = *(const v4u*)(src + VC); } } while (0)
#define MB_STORE() do { _Pragma("unroll") for (int i = 0; i < 4; ++i) { const int cidx = tid + 512 * i, row = cidx >> 3, ch = cidx & 7; \
        *(LAS v4u*)(lds + MB_K + row * 144 + ch * 16) = kreg[i]; *(LAS v4u*)(lds + MB_V + row * 144 + ch * 16) = vreg[i]; } } while (0)
#define MB_EXISTS(st, k) ((st) == 0 ? (k) < 2 : (C.wave + 8 * (k)) < ((cnt[(st) - 1] + 15) >> 4))
#define MB_QID(st, k, qid, valid) do { if ((st) == 0) { const int it_ = (k) ? 15 - C.wave : C.wave; qid = 16 * it_ + i16; valid = true; } \
        else { const int pos_ = 16 * (C.wave + 8 * (k)) + i16; valid = pos_ < cnt[(st) - 1]; qid = lists[((st) - 1) * 256 + (valid ? pos_ : 0)]; } } while (0)
#define MB_QLOAD(qid, d0, d1) do { const bf16* qp_ = Zb + (size_t)(qb * 256 + (qid)) * ZC + QC + h * 64 + 8 * (lane >> 4); d0 = *(const bf16x8*)qp_; d1 = *(const bf16x8*)(qp_ + 32); } while (0)
    MB_LOAD(qb);
    __syncthreads();
    for (int step = 0; step <= qb; ++step) {
        __syncthreads();
        MB_STORE();
        __syncthreads();
        if (step < qb) MB_LOAD(step);
#pragma unroll 1
        for (int k = 0; MB_EXISTS(step, k); ++k) {
            int cqid; bool cvalid; bf16x8 cq0, cq1;
            MB_QID(step, k, cqid, cvalid); MB_QLOAD(cqid, cq0, cq1);
            if (step == 0) { const int it = k ? 15 - C.wave : C.wave; moba_item<true>(cq0, cq1, lds, lane, qb, qb, cqid, true, (16 * it + 15) >> 5); }
            else moba_item<false>(cq0, cq1, lds, lane, qb, step - 1, cqid, cvalid, 7);
        }
    }
#undef MB_EXISTS
#undef MB_QID
#undef MB_QLOAD
#undef MB_LOAD
#undef MB_STORE
    __syncthreads();
    {
        const int qd = tid >> 1, hf = tid & 1;
        const LAS float* orow = (const LAS float*)(lds + MB_OST) + qd * 64; const float inv = __builtin_amdgcn_rcpf(((const LAS float*)(lds + MB_L))[qd]);
        bf16* op = (bf16*)(C.ws + WS_O) + (size_t)(b * SEQ + qb * 256 + qd) * OC + 768 + h * 64 + 32 * hf;
#pragma unroll
        for (int k = 0; k < 4; ++k) { const f32x4 a = *(const LAS f32x4*)(orow + 4 * ((8 * hf + 2 * k) ^ (qd & 15))), bq = *(const LAS f32x4*)(orow + 4 * ((8 * hf + 2 * k + 1) ^ (qd & 15)));
            v4u w; w.x = pk2(a[0] * inv, a[1] * inv); w.y = pk2(a[2] * inv, a[3] * inv); w.z = pk2(bq[0] * inv, bq[1] * inv); w.w = pk2(bq[2] * inv, bq[3] * inv);
            *(v4u*)(op + 8 * k) = w; }
    }
    __syncthreads();
}

__device__ __forceinline__ void lru_unit(const Ctx& C, const Params& p, int l, int unit) {
    const int tc = unit >> 6, b = (unit >> 3) & 7, nb = unit & 7, c0 = nb * 64;
    const bf16* Zb = (const bf16*)(C.ws + WS_Z) + (size_t)b * SEQ * ZC;
    bf16* Ob = (bf16*)(C.ws + WS_O) + (size_t)b * SEQ * OC;
    float* carr = (float*)(C.ws + WS_LC) + (size_t)(l * 1024) * 64;
    unsigned* flg = (unsigned*)(C.ws + WS_LF) + (size_t)(l * 1024) * 16;
    LAS unsigned char* XCB = C.lds;
    LAS float* RF = (LAS float*)(C.lds + 18432);
    LAS float* IF = (LAS float*)(C.lds + 18432 + 32768);
    LAS float* AGG = (LAS float*)(C.lds + 83968);
    LAS float* CAR = (LAS float*)(C.lds + 88064);
    LAS float* CARP = (LAS float*)(C.lds + 88320);
    LAS float* CIN = (LAS float*)(C.lds + 88576);
    LAS bf16* HL = (LAS bf16*)(C.lds + 90112);
    LAS bf16* PGL = (LAS bf16*)(C.lds + 122880);
    const int tid = C.tid, lane = C.lane, i16 = lane & 15, g = lane >> 4, c = tid & 63, tg = tid >> 6;
    const int ch = c0 + c;
    const float* cwp = p.in[4] + (size_t)l * 4 * 512;
    const float cw0 = cwp[ch], cw1 = cwp[512 + ch], cw2 = cwp[1024 + ch], cw3 = cwp[1536 + ch];
    const float cb = p.in[5][l * 512 + ch], ba = p.in[7][l * 512 + ch], bx = p.in[9][l * 512 + ch];
    const float lam = p.in[10][l * 512 + ch];
    const float logu = -8.0f * log1pf(expf(-lam));
    const bf16* WaT = (const bf16*)wla_ptr(C.ws, l) + nb * 4096;
    const bf16* WxT = (const bf16*)wlx_ptr(C.ws, l) + nb * 4096;
    bf16x8 wa[4][2], wx[4][2];
#pragma unroll
    for (int nt = 0; nt < 4; ++nt)
#pragma unroll
        for (int ks = 0; ks < 2; ++ks) { wa[nt][ks] = *(const bf16x8*)(WaT + (16 * nt + i16) * 64 + 32 * ks + 8 * g); wx[nt][ks] = *(const bf16x8*)(WxT + (16 * nt + i16) * 64 + 32 * ks + 8 * g); }
    if (tid < 64) { CAR[tid] = 0.f; CARP[tid] = 1.f; }
    __syncthreads();
#pragma unroll 1
    for (int tile = 0; tile < 2; ++tile) {
        const int tl0 = tile * 128 + 16 * tg, t0 = tc * 256 + tl0;
        float xw[19], gbv[16], xc[16];
#pragma unroll
        for (int k = 0; k < 19; ++k) { const int t = t0 - 3 + k; xw[k] = (t >= 0) ? bf2f(Zb[(size_t)t * ZC + XB + ch]) : 0.f; }
#pragma unroll
        for (int i = 0; i < 16; ++i) gbv[i] = bf2f(Zb[(size_t)(t0 + i) * ZC + GB + ch]);
#pragma unroll
        for (int i = 0; i < 16; ++i) { xc[i] = cb + cw0 * xw[i] + cw1 * xw[i + 1] + cw2 * xw[i + 2] + cw3 * xw[i + 3];
            *(LAS bf16*)(XCB + (16 * tg + i) * 144 + c * 2) = f2bf_hw(xc[i]); }
        __syncthreads();
        {
            const LAS unsigned char* ap = XCB + (16 * C.wave + i16) * 144 + 16 * g;
            const bf16x8 a0 = *(const LAS bf16x8*)ap, a1 = *(const LAS bf16x8*)(ap + 64);
#pragma unroll
            for (int nt = 0; nt < 4; ++nt) {
                f32x4 r = mfma16(a0, wa[nt][0], (f32x4){0.f, 0.f, 0.f, 0.f}); r = mfma16(a1, wa[nt][1], r);
                f32x4 x = mfma16(a0, wx[nt][0], (f32x4){0.f, 0.f, 0.f, 0.f}); x = mfma16(a1, wx[nt][1], x);
#pragma unroll
                for (int jj = 0; jj < 4; ++jj) { RF[(16 * C.wave + 4 * g + jj) * 64 + 16 * nt + i16] = r[jj]; IF[(16 * C.wave + 4 * g + jj) * 64 + 16 * nt + i16] = x[jj]; }
            }
        }
        __syncthreads();
        float av[16], bt[16]; float Ap = 1.f, hl = 0.f;
#pragma unroll
        for (int i = 0; i < 16; ++i) {
            const float r = sigmoidf_(RF[(16 * tg + i) * 64 + c] + ba), ig = sigmoidf_(IF[(16 * tg + i) * 64 + c] + bx);
            const float la = r * logu; av[i] = __expf(la);
            const float x2 = 2.0f * la;
            const float em = -x2 * (1.0f + x2 * (0.5f + x2 * (0.16666667f + x2 * (0.041666668f + x2 * (0.0083333338f + x2 * 0.0013888889f)))));
            bt[i] = __builtin_amdgcn_sqrtf(em) * (ig * xc[i]);
            Ap *= av[i]; hl = av[i] * hl + bt[i];
        }
        AGG[(tg * 64 + c) * 2] = Ap; AGG[(tg * 64 + c) * 2 + 1] = hl;
        __syncthreads();
        float hcur = CAR[c], pcur = CARP[c];
        for (int k = 0; k < tg; ++k) { const float ak = AGG[(k * 64 + c) * 2]; hcur = ak * hcur + AGG[(k * 64 + c) * 2 + 1]; pcur *= ak; }
#pragma unroll
        for (int i = 0; i < 16; ++i) {
            hcur = av[i] * hcur + bt[i]; pcur *= av[i];
            const float x = gbv[i], y = 0.7978845608028654f * (x + 0.044715f * x * x * x);
            const float th = 1.0f - 2.0f * __builtin_amdgcn_rcpf(__expf(2.0f * y) + 1.0f);
            const float ge = 0.5f * x * (1.0f + th);
            { const unsigned w2 = pk2(hcur * ge, pcur * ge); HL[(tl0 + i) * 64 + c] = (bf16)(w2 & 0xffffu); PGL[(tl0 + i) * 64 + c] = (bf16)(w2 >> 16); }
        }
        __syncthreads();
        if (tg == 7) { CAR[c] = hcur; CARP[c] = pcur; }
    }
    __syncthreads();
    if (tid < 64) {
        float cin = 0.f;
        if (tc > 0) {
            unsigned* pf = flg + (size_t)(unit - 64) * 16;
            while (__hip_atomic_load(pf, __ATOMIC_RELAXED, __HIP_MEMORY_SCOPE_AGENT) == 0u) __builtin_amdgcn_s_sleep(2);
            cin = __hip_atomic_load(carr + (size_t)(unit - 64) * 64 + tid, __ATOMIC_RELAXED, __HIP_MEMORY_SCOPE_AGENT);
        }
        CIN[tid] = cin;
        if (tc < 15) {
            __hip_atomic_store(carr + (size_t)unit * 64 + tid, CARP[tid] * cin + CAR[tid], __ATOMIC_RELAXED, __HIP_MEMORY_SCOPE_AGENT);
            asm volatile("s_waitcnt vmcnt(0)" ::: "memory");
            if (tid == 0) __hip_atomic_store(flg + (size_t)unit * 16, 1u, __ATOMIC_RELAXED, __HIP_MEMORY_SCOPE_AGENT);
        }
    }
    __syncthreads();
#pragma unroll
    for (int k = 0; k < 4; ++k) {
        const int w = tid + 512 * k, tl = w >> 3, cg8 = w & 7;
        const v4u hv = *(const LAS v4u*)(HL + tl * 64 + cg8 * 8), pv = *(const LAS v4u*)(PGL + tl * 64 + cg8 * 8);
        const f32x4 ci0 = *(const LAS f32x4*)(CIN + cg8 * 8), ci1 = *(const LAS f32x4*)(CIN + cg8 * 8 + 4);
        v4u o;
        o.x = pk2(bflo(hv.x) + bflo(pv.x) * ci0[0], bfhi(hv.x) + bfhi(pv.x) * ci0[1]);
        o.y = pk2(bflo(hv.y) + bflo(pv.y) * ci0[2], bfhi(hv.y) + bfhi(pv.y) * ci0[3]);
        o.z = pk2(bflo(hv.z) + bflo(pv.z) * ci1[0], bfhi(hv.z) + bfhi(pv.z) * ci1[1]);
        o.w = pk2(bflo(hv.w) + bflo(pv.w) * ci1[2], bfhi(hv.w) + bfhi(pv.w) * ci1[3]);
        *(v4u*)(Ob + (size_t)(tc * 256 + tl) * OC + 256 + c0 + cg8 * 8) = o;
    }
    __syncthreads();
}

#define XB_TMO      128
#define XB_XCNT(j)  (256  + 64 * (j))
#define XB_XSUB(j)  (1280 + 64 * (j))
#define XB_XGEN(j)  (2304 + 64 * (j))
#define XB_TOP      3328
#define XB_TOPGEN   3392
#define XCD_BAR_WORDS 3456
#define XB_SPIN_CAP (1u << 18)

__device__ __forceinline__ unsigned xb_ld(unsigned* p)              { return __hip_atomic_load(p, __ATOMIC_RELAXED, __HIP_MEMORY_SCOPE_AGENT); }
__device__ __forceinline__ unsigned xb_add(unsigned* p, unsigned v) { return __hip_atomic_fetch_add(p, v, __ATOMIC_RELAXED, __HIP_MEMORY_SCOPE_AGENT); }
__device__ __forceinline__ unsigned xb_xcc_id() { return (unsigned)__builtin_amdgcn_s_getreg((3 << 11) | 20) & 0xFu; }
#define XB_SPIN(cond, bar) do { unsigned _sp = 0; while (cond) { __builtin_amdgcn_s_sleep(1); \
    if ((++_sp & 255u) == 0u) { if (xb_ld(&(bar)[XB_TMO])) break; if (_sp > XB_SPIN_CAP) { atomicAdd(&(bar)[XB_TMO], 1u); break; } } } } while (0)

struct XcdBarrier {
    unsigned* bar; unsigned x;
    volatile LAS unsigned* st;
};

__device__ __forceinline__ XcdBarrier xcd_barrier_post(unsigned* bar, volatile LAS unsigned* st) {
    XcdBarrier b; b.bar = bar; b.x = xb_xcc_id(); b.st = st;
    if (threadIdx.x == 0) (void)xb_add(&bar[XB_XCNT(b.x)], 1u);
    return b;
}
__device__ __forceinline__ void xcd_barrier_complete(unsigned* bar, unsigned x, unsigned& nloc, unsigned& nx) {
    const unsigned G = gridDim.x * gridDim.y * gridDim.z;
    unsigned sum, cnt, mine, sp = 0u;
    for (;;) {
        sum = 0u; cnt = 0u; mine = 0u;
#pragma unroll
        for (unsigned j = 0; j < 16; ++j) { const unsigned c = xb_ld(&bar[XB_XCNT(j)]); sum += c; cnt += (c > 0u) ? 1u : 0u; mine = (j == x) ? c : mine; }
        if (sum == G) break;
        __builtin_amdgcn_s_sleep(1);
        if ((++sp & 255u) == 0u) { if (xb_ld(&bar[XB_TMO])) break; if (sp > XB_SPIN_CAP) { atomicAdd(&bar[XB_TMO], 1u); break; } }
    }
    nloc = mine > 0u ? mine : 1u; nx = cnt > 0u ? cnt : 1u;
}

__device__ __forceinline__ void xcd_barrier(const XcdBarrier& b) {
    asm volatile("s_waitcnt vmcnt(0)" ::: "memory");
    __syncthreads();
    if (threadIdx.x == 0) {
        unsigned* bar = b.bar;
        __builtin_amdgcn_s_waitcnt(0);
        unsigned nloc = b.st[0], nx = b.st[1];
        if (nloc == 0u) { xcd_barrier_complete(bar, b.x, nloc, nx); b.st[0] = nloc; b.st[1] = nx; }
        const unsigned old = xb_add(&bar[XB_XSUB(b.x)], 1u);
        const unsigned gen = old / nloc;
        if (old + 1u == (gen + 1u) * nloc) {
            __builtin_amdgcn_fence(__ATOMIC_RELEASE, "agent");
            asm volatile("s_waitcnt vmcnt(0)" ::: "memory");
            const unsigned og = xb_add(&bar[XB_TOP], 1u);
            const unsigned tg = og / nx;
            if (og + 1u == (tg + 1u) * nx) xb_add(&bar[XB_TOPGEN], 1u);
            else XB_SPIN(xb_ld(&bar[XB_TOPGEN]) == tg, bar);
            __builtin_amdgcn_fence(__ATOMIC_ACQUIRE, "agent");
            xb_add(&bar[XB_XGEN(b.x)], 1u);
            asm volatile("s_waitcnt vmcnt(0)" ::: "memory");
        } else {
            XB_SPIN(xb_ld(&bar[XB_XGEN(b.x)]) == gen, bar);
            __builtin_amdgcn_fence(__ATOMIC_ACQUIRE, "agent");
            asm volatile("s_waitcnt vmcnt(0)" ::: "memory");
        }
    }
    __syncthreads();
}

#define GSYNC() xcd_barrier(xbar)
#define MKCTX() Ctx C; size_t z_ = 0; { int t_ = threadIdx.x; asm volatile("" : "+s"(z_), "+v"(t_)); unsigned char* ws_ = p.ws + z_; const float* rb_ = p.in[1] + z_; \
    C.lds = (LAS unsigned char*)lds_raw + 64; C.tid = t_; C.lane = t_ & 63; C.wave = __builtin_amdgcn_readfirstlane(t_ >> 6); C.relb = rb_; C.ws = ws_; }
__global__ void __launch_bounds__(512) hybrid_fwd(Params p) {
    extern __shared__ __attribute__((aligned(16))) unsigned char lds_raw[];
    cg::grid_group grid = cg::this_grid();
    const int G = gridDim.x;
    if (threadIdx.x < 16) ((LAS unsigned*)lds_raw)[threadIdx.x] = 0u;
    __syncthreads();
    const XcdBarrier xbar = xcd_barrier_post((unsigned*)(p.ws + WS_CTL) + 16384, (volatile LAS unsigned*)((LAS unsigned char*)lds_raw + 16));
    volatile LAS int& s_unit = *(volatile LAS int*)(LAS unsigned char*)lds_raw;

#pragma nounroll
    for (int l = 0; l < 2; ++l) {
        { MKCTX(); const int gw = blockIdx.x * 8 + C.wave, NGW = G * 8;
          const float* xin = (l == 0) ? p.in[0] : p.out; xin += z_;
          bf16* Hb = (bf16*)(C.ws + WS_H);
          if (l == 0) { prep_weights(C, p, 0, gw, NGW, 0, PW_IN); prep_weights(C, p, 0, gw, NGW, PW_ALL, PW_END); }
          { int m = gw; for (; m + 3 * NGW < MTOK; m += 4 * NGW) rms_rows_bf16<4>(xin, p.in[2] + l * DM, Hb, m, NGW, C.lane); for (; m < MTOK; m += NGW) rms_rows_bf16<1>(xin, p.in[2] + l * DM, Hb, m, NGW, C.lane); }
          if (l == 0 && blockIdx.x < 8) { float* T = (float*)(C.ws + WS_TABC) + blockIdx.x * 4096; for (int d = C.tid; d < 4096; d += 512) T[d] = C.relb[rel_bucket_dev(d) * 20 + 12 + blockIdx.x] * 1.4426950408889634f; }
          if (l == 0 && blockIdx.x == 8) { float* T = (float*)(C.ws + WS_TABA); for (int idx = C.tid; idx < 12 * 132; idx += 512) { const int gj = idx / 132, dlt = idx % 132, grp = gj >> 2; T[idx] = C.relb[rel_bucket_dev((dlt > 128 ? 128 : dlt) << (2 * grp)) * 20 + gj]; } } }
        if (p.ws == nullptr) grid.sync();
        GSYNC();
#ifndef NO_P1
        { MKCTX(); pg8::Gemm gm{(const bf16*)(C.ws + WS_H), (const bf16*)win_ptr(C.ws, l), MTOK, ZC, 1024}; pg8::StaticOrder S; S.init(MTOK, ZC, G, (int)blockIdx.x);
          EpiZ E{(bf16*)(C.ws + WS_Z), (float*)(C.ws + WS_KM) + (size_t)l * 128 * 512};
          pg8::gemm_phase<EpiZ, pg8::StaticOrder, true, true>(C.lds, gm, S, E, 1024);
          { const int nwg = (MTOK / 256) * (ZC / 256), rounds = (nwg + G - 1) / G, rem = nwg - (rounds - 1) * G;
            const bool idle = rem < G; const int gwI = idle ? ((int)blockIdx.x - rem) * 8 + C.wave : (int)blockIdx.x * 8 + C.wave, ngwI = idle ? (G - rem) * 8 : G * 8;
            if (!idle || (int)blockIdx.x >= rem) { prep_weights(C, p, l, gwI, ngwI, PW_IN, PW_ALL);
                if (l == 0) { prep_weights(C, p, 1, gwI, ngwI, 0, PW_IN); prep_weights(C, p, 1, gwI, ngwI, PW_ALL, PW_END); } } } }
#endif
        GSYNC();
        for (;;) {
            MKCTX();
            unsigned* ctl = (unsigned*)(C.ws + WS_CTL);
            __syncthreads();
            if (C.tid == 0) s_unit = (int)atomicAdd(ctl + 64 * (1 + l), 1u);
            __syncthreads();
            const int u = s_unit;
            __syncthreads();
            if (u >= 1024 + 1024 + 512) break;
#ifndef NO_LRU
            if (u >= 1536) lru_unit(C, p, l, u - 1536);
#endif
#ifndef NO_MOBA
            if (u >= 512 && u < 1536) moba_unit(C, u - 512, (const float*)(C.ws + WS_KM) + (size_t)l * 128 * 512);
#endif
#ifndef NO_A
            if (u < 512) attnA_unit(C, u);
#endif
        }
        GSYNC();
#ifndef NO_P3
        { MKCTX(); ProdOrder S; S.init(G, (int)blockIdx.x);
          pg8::Gemm gm{(const bf16*)(C.ws + WS_O), (const bf16*)(C.ws + WS_W + W_PA), MTOK, 3072, 512}; EpiTmp3 E{(bf16*)(C.ws + WS_TMP3)};
          pg8::gemm_phase<EpiTmp3, ProdOrder, true, true>(C.lds, gm, S, E, OC);
        }
        { MKCTX(); GateOrder S; S.init(G, (int)blockIdx.x);
          pg8::Gemm gm{(const bf16*)(C.ws + WS_H), (const bf16*)win_ptr(C.ws, l) + (size_t)ZC * 1024, MTOK, 3072, 1024}; EpiGate3 E{(bf16*)(C.ws + WS_TMP3)};
          pg8::gemm_phase<EpiGate3, GateOrder, true, true>(C.lds, gm, S, E, 1024); }
#endif
        GSYNC();
#ifndef NO_P4
        { MKCTX(); pg8::Gemm gm{(const bf16*)(C.ws + WS_TMP3), (const bf16*)(C.ws + WS_W + W_OUT), MTOK, DM, 1024}; pg8::StaticOrder S; S.init(MTOK, DM, G, (int)blockIdx.x);
          const float* xin = (l == 0) ? p.in[0] : p.out; float* xo = p.out; xin += z_; xo += z_;
          EpiResid E{xin, xo};
          pg8::gemm_phase<EpiResid, pg8::StaticOrder, true, true>(C.lds, gm, S, E, 3072); }
#endif
        GSYNC();
        { MKCTX(); const int gw = blockIdx.x * 8 + C.wave, NGW = G * 8; float* xo = p.out + z_; bf16* Hb = (bf16*)(C.ws + WS_H);
          { int m = gw; for (; m + 3 * NGW < MTOK; m += 4 * NGW) rms_rows_bf16<4>(xo, p.in[15] + l * DM, Hb, m, NGW, C.lane); for (; m < MTOK; m += NGW) rms_rows_bf16<1>(xo, p.in[15] + l * DM, Hb, m, NGW, C.lane); } }
        GSYNC();
#ifndef NO_P6
        { MKCTX(); pg8::Gemm gm{(const bf16*)(C.ws + WS_H), (const bf16*)(C.ws + WS_W + W_GU), MTOK, 5632, 1024}; pg8::StaticOrder S; S.init(MTOK, 5632, G, (int)blockIdx.x);
          EpiSwiGLU E{(bf16*)(C.ws + WS_FFH)};
          pg8::gemm_phase<EpiSwiGLU, pg8::StaticOrder, true, true>(C.lds, gm, S, E, 1024);
        }
#endif
        GSYNC();
#ifndef NO_P7
        { MKCTX(); pg8::Gemm gm{(const bf16*)(C.ws + WS_FFH), (const bf16*)(C.ws + WS_W + W_DOWN), MTOK, DM, FFN}; pg8::StaticOrder S; S.init(MTOK, DM, G, (int)blockIdx.x);
          float* xo = p.out + z_;
          EpiResid E{xo, xo};
          pg8::gemm_phase<EpiResid, pg8::StaticOrder, true, true>(C.lds, gm, S, E, FFN); }
#endif
        GSYNC();
    }
    { MKCTX(); const int gw = blockIdx.x * 8 + C.wave, NGW = G * 8; float* xo = p.out + z_;
      { int m = gw; for (; m + 3 * NGW < MTOK; m += 4 * NGW) rms_rows_f32<4>(xo, p.in[18], m, NGW, C.lane); for (; m < MTOK; m += NGW) rms_rows_f32<1>(xo, p.in[18], m, NGW, C.lane); } }
}

extern "C" void kernel_launch(void* const* d_in, const int* in_sizes, int n_in, void* d_out, int out_size, void* d_ws, size_t ws_size, hipStream_t stream) {
    static int grid_blocks = 0;
    if (grid_blocks == 0) {
        if (n_in != 19 || out_size != MTOK * DM || ws_size < WS_END) { fprintf(stderr, "kernel_launch: unexpected shapes: n_in %d out %d ws %zu (need %zu)\n", n_in, out_size, ws_size, (size_t)WS_END); grid_blocks = -1; return; }
        int dev = 0, cus = 0, per_cu = 0;
        (void)hipGetDevice(&dev);
        (void)hipDeviceGetAttribute(&cus, hipDeviceAttributeMultiprocessorCount, dev);
        if (hipFuncSetAttribute((const void*)hybrid_fwd, hipFuncAttributeMaxDynamicSharedMemorySize, LDS_BYTES) != hipSuccess) { fprintf(stderr, "kernel_launch: hipFuncSetAttribute failed\n"); grid_blocks = -1; return; }
        if (hipOccupancyMaxActiveBlocksPerMultiprocessor(&per_cu, (const void*)hybrid_fwd, 512, LDS_BYTES) != hipSuccess || per_cu < 1) { fprintf(stderr, "kernel_launch: occupancy query gave %d\n", per_cu); per_cu = 1; }
        (void)hipGetLastError();
        grid_blocks = cus * per_cu;
        fprintf(stderr, "kernel_launch: grid %d (cus %d x %d)\n", grid_blocks, cus, per_cu);
    }
    if (grid_blocks < 0) return;
    (void)hipMemsetAsync((char*)d_ws + WS_CTL, 0, CTL_BYTES, stream);
    Params p{};
    for (int i = 0; i < 19; ++i) p.in[i] = (const float*)d_in[i];
    p.out = (float*)d_out; p.ws = (unsigned char*)d_ws;
    void* args[] = {&p};
    hipError_t e = hipLaunchCooperativeKernel((const void*)hybrid_fwd, dim3(grid_blocks), dim3(512), args, LDS_BYTES, stream);
    if (e != hipSuccess) fprintf(stderr, "cooperative launch failed: %s (grid %d)\n", hipGetErrorString(e), grid_blocks);
}
```

```cpp
#include <hip/hip_runtime.h>
#include <hip/hip_cooperative_groups.h>
#include <cstdio>
#include <cstdint>
namespace cg = cooperative_groups;
namespace pg8 {
#define PG8_LAS __attribute__((address_space(3)))
typedef unsigned short bf16_t;
typedef short bf16x8 __attribute__((ext_vector_type(8)));
typedef float f32x4 __attribute__((ext_vector_type(4)));
typedef unsigned u32x4 __attribute__((ext_vector_type(4)));
constexpr int BM = 256, BK = 64, HALF = 128, HTB = HALF * BK * 2  , STAGE_BYTES = 8 * HTB, NXCD = 8, WGM = 8;

__host__ __device__ __forceinline__ int lds_byte(int r, int c) { const int st = (r >> 4) * 2 + (c >> 5), rr = r & 15, cc = c & 31, ob = rr * 64 + cc * 2; return st * 1024 + (ob ^ (((ob >> 9) & 1) << 5)); }
__host__ __device__ __forceinline__ void stage_rc(int b, int& R, int& C) { const int st = b / 1024, sb = b % 1024, swz = sb ^ (((sb >> 9) & 1) << 5); R = (st >> 1) * 16 + swz / 64; C = (st & 1) * 32 + (swz % 64) / 2; }
__host__ __device__ __forceinline__ int perm32(int rho) { const int n = rho >> 4, i = rho & 15; return 8 * (i >> 2) + 4 * n + (i & 3); }

struct Unit { int pm, pn; };
struct Gemm { const bf16_t* A; const bf16_t* Bt; int M, N, K; };

struct StaticOrder {
    int nM, nN, nwg, G, c;
    __host__ __device__ void init(int M, int N, int G_, int c_) { nM = M / BM; nN = N / BM; nwg = nM * nN; G = G_; c = c_; }
    __host__ __device__ bool next(int i, Unit& u) const {
        const long L = (long)i * G + c; if (L >= nwg) return false;
        int wgid = (int)L; { const int q = nwg / NXCD, r = nwg % NXCD, xcd = wgid % NXCD, off = wgid / NXCD; wgid = (xcd < r ? xcd * (q + 1) : r * (q + 1) + (xcd - r) * q) + off; }
        const int nig = WGM * nN, gid = wgid / nig, fm = gid * WGM, gsz = (nM - fm) < WGM ? (nM - fm) : WGM;
        u.pm = fm + ((wgid % nig) % gsz); u.pn = (wgid % nig) / gsz; return true;
    }
    __device__ __forceinline__ void a_ready(const Unit&) const {}
    __device__ __forceinline__ void done(const Unit&) const {}
    __device__ __forceinline__ size_t aoff(const Unit&) const { return 0; }
    __device__ __forceinline__ int nt(const Unit&, int d) const { return d; }
};

__device__ __forceinline__ unsigned cvt_pk_bf16(float lo, float hi) { unsigned r; asm volatile("v_cvt_pk_bf16_f32 %0, %1, %2" : "=v"(r) : "v"(lo), "v"(hi)); return r; }
typedef float f32x2 __attribute__((ext_vector_type(2)));
__device__ __forceinline__ f32x2 gelu_pk(f32x2 v) {
    const f32x2 av = __builtin_elementwise_abs(v), d = av * 0.2316418882f + 1.0f;
    f32x2 t; t.x = __builtin_amdgcn_rcpf(d.x); t.y = __builtin_amdgcn_rcpf(d.y);
    f32x2 q = t * 0.5307027145f + (-0.7265760135f); q = q * t + 0.7107068705f; q = q * t + (-0.142248368f); q = q * t + 0.127414796f; q = q * t;
    const f32x2 s = (v * v) * (-0.72134752044f);
    f32x2 e; e.x = __builtin_amdgcn_exp2f(s.x); e.y = __builtin_amdgcn_exp2f(s.y);
    const f32x2 m = v * (q * e), r = v - m;
    f32x2 o; o.x = v.x < 0.f ? m.x : r.x; o.y = v.y < 0.f ? m.y : r.y; return o;
}

template <int ACT  > struct EpiBf16 {
    static constexpr bool PERM = true, AFTER_DRAIN = false; static_assert(ACT == 0 || ACT == 1, "EpiBf16: ACT is 0 (none) or 1 (gelu_pk)");
    bf16_t* O; int ldc; const float* bias; int split_cols; size_t split_stride; float scale0;
    __device__ __forceinline__ void operator()(const f32x4 (&acc)[2][2][4][2], const Unit& u, int wr, int wc, int fr, int fq) const {
        const int row0 = u.pm * BM + wr * 64 + fr; int colt = u.pn * BM; bf16_t* base = O;
        float sc = 1.f; if (split_cols) { const int t = colt / split_cols; base += (size_t)t * split_stride; colt -= t * split_cols; if (t == 0) sc = scale0; }
        const int col0 = colt + wc * 32 + 8 * fq, bcol0 = u.pn * BM + wc * 32 + 8 * fq;
        f32x4 bv[2][2];
#pragma unroll
        for (int bj = 0; bj < 2; ++bj)
#pragma unroll
            for (int n = 0; n < 2; ++n) bv[bj][n] = bias ? *(const f32x4*)(bias + bcol0 + bj * HALF + 4 * n) : (f32x4){0.f, 0.f, 0.f, 0.f};
#pragma unroll
        for (int ai = 0; ai < 2; ++ai)
#pragma unroll
            for (int m = 0; m < 4; ++m) { bf16_t* rowp = base + (size_t)(row0 + ai * HALF + m * 16) * ldc + col0;
#pragma unroll
                for (int bj = 0; bj < 2; ++bj) { f32x4 v0 = acc[ai][bj][m][0] + bv[bj][0], v1 = acc[ai][bj][m][1] + bv[bj][1];
                    if (ACT == 1) { f32x2 a = gelu_pk((f32x2){v0[0], v0[1]}), b = gelu_pk((f32x2){v0[2], v0[3]}), c = gelu_pk((f32x2){v1[0], v1[1]}), d = gelu_pk((f32x2){v1[2], v1[3]});
                        v0 = (f32x4){a.x, a.y, b.x, b.y}; v1 = (f32x4){c.x, c.y, d.x, d.y}; }
                    v0 = v0 * sc; v1 = v1 * sc; u32x4 w; w.x = cvt_pk_bf16(v0[0], v0[1]); w.y = cvt_pk_bf16(v0[2], v0[3]); w.z = cvt_pk_bf16(v1[0], v1[1]); w.w = cvt_pk_bf16(v1[2], v1[3]);
                    *(u32x4*)(rowp + bj * HALF) = w; } }
    }
};
template <class Epi, class Sched, bool ALIGN_EPI = false, bool SP2 = false>
__device__ __forceinline__ void gemm_phase(PG8_LAS unsigned char* lds, const Gemm g, const Sched& S, const Epi& E, const int lda) {
    int tid_ = threadIdx.x; const bf16_t* gA = g.A; const bf16_t* gB = g.Bt;
    asm volatile("" : "+v"(tid_), "+s"(gA), "+s"(gB));
    const int tid = tid_, wid = __builtin_amdgcn_readfirstlane(tid >> 6), lane = tid & 63, wr = wid >> 2, wc = wid & 3, fr = lane & 15, fq = lane >> 4;
    const int K = g.K; int nt = K / BK;
    unsigned voffA[2], voffB[2];
#pragma unroll
    for (int i = 0; i < 2; ++i) { int R, C; stage_rc(tid * 16 + i * 8192, R, C); const int Rb = Epi::PERM ? ((R & ~31) + perm32(R & 31)) : R;
        voffA[i] = (unsigned)(R * lda + C) * 2u; voffB[i] = (unsigned)(Rb * K + C) * 2u; }
    const size_t kstep = (size_t)(BK * 2);
    const size_t hstep = (size_t)HALF * K * 2, hstepA = (size_t)HALF * lda * 2;
    const size_t tstep = 2 * hstep, tstepA = 2 * hstepA;
    const unsigned ldsw = (unsigned)wid * 1024u;
    const int aoff = lds_byte(wr * 64 + fr, fq * 8), boff = lds_byte(wc * 32 + fr, fq * 8);
#define PG8_SA(b, h) (((b) * 2 + (h)) * HTB)
#define PG8_SB(b, h) ((4 + (b) * 2 + (h)) * HTB)
#define PG8_STAGE(bufoff, gbase, voff) do { _Pragma("unroll") for (int _i = 0; _i < 2; ++_i) \
        __builtin_amdgcn_global_load_lds((const unsigned*)((const char*)(gbase) + (voff)[_i]), (PG8_LAS unsigned*)(lds + (bufoff) + ldsw + _i * 8192), 16, 0, 0); } while (0)
#define PG8_LDA(dst, b, h) do { _Pragma("unroll") for (int m = 0; m < 4; ++m) _Pragma("unroll") for (int k = 0; k < 2; ++k) dst[m][k] = *(const PG8_LAS bf16x8*)(lds + PG8_SA(b, h) + aoff + m * 2048 + k * 1024); } while (0)
#define PG8_LDB(dst, b, h) do { _Pragma("unroll") for (int n = 0; n < 2; ++n) _Pragma("unroll") for (int k = 0; k < 2; ++k) dst[n][k] = *(const PG8_LAS bf16x8*)(lds + PG8_SB(b, h) + boff + n * 2048 + k * 1024); } while (0)
#define PG8_MMA(ai, bj, At, Bt) do { __builtin_amdgcn_s_setprio(1); _Pragma("unroll") for (int m = 0; m < 4; ++m) _Pragma("unroll") for (int n = 0; n < 2; ++n) _Pragma("unroll") for (int k = 0; k < 2; ++k) \
        acc[ai][bj][m][n] = __builtin_amdgcn_mfma_f32_16x16x32_bf16(Bt[n][k], At[m][k], acc[ai][bj][m][n], 0, 0, 0); __builtin_amdgcn_s_setprio(0); } while (0)
#define PG8_WAIT_V(n) asm volatile("s_waitcnt vmcnt(" #n ")" ::: "memory")
#define PG8_WAIT_L(n) asm volatile("s_waitcnt lgkmcnt(" #n ")" ::: "memory")
#define PG8_BAR __builtin_amdgcn_s_barrier()
#define PG8_SCHED __builtin_amdgcn_sched_barrier(0)
    Unit cur, nxt; int ui = 0;
    if (!S.next(0, cur)) return;
    f32x4 acc[2][2][4][2];
#pragma unroll
    for (int a = 0; a < 2; ++a)
#pragma unroll
        for (int b = 0; b < 2; ++b)
#pragma unroll
            for (int m = 0; m < 4; ++m)
#pragma unroll
                for (int n = 0; n < 2; ++n) acc[a][b][m][n] = (f32x4){0.f, 0.f, 0.f, 0.f};
    bf16x8 At[4][2], B0[2][2], B1[2][2];
    const char* cA = (const char*)gA + (size_t)cur.pm * tstepA + S.aoff(cur); const char* cB = (const char*)gB + (size_t)cur.pn * tstep;
    nt = S.nt(cur, K / BK);
    S.a_ready(cur);
    if constexpr (SP2) {
        PG8_STAGE(PG8_SB(0, 0), cB, voffB); PG8_STAGE(PG8_SB(0, 1), cB + hstep, voffB); PG8_STAGE(PG8_SA(0, 0), cA, voffA); PG8_STAGE(PG8_SA(0, 1), cA + hstepA, voffA);
        if (wr == 1) PG8_BAR;
        PG8_WAIT_V(2); PG8_BAR;
        PG8_STAGE(PG8_SB(1, 0), cB + kstep, voffB); PG8_STAGE(PG8_SA(1, 0), cA + kstep, voffA); PG8_STAGE(PG8_SB(1, 1), cB + hstep + kstep, voffB);
        PG8_WAIT_V(6); PG8_BAR;
    } else {
        PG8_STAGE(PG8_SB(0, 0), cB, voffB); PG8_STAGE(PG8_SA(0, 0), cA, voffA); PG8_STAGE(PG8_SB(0, 1), cB + hstep, voffB); PG8_STAGE(PG8_SA(0, 1), cA + hstepA, voffA);
        if (wr == 1) PG8_BAR;
        PG8_WAIT_V(4); PG8_BAR;
        PG8_STAGE(PG8_SB(1, 0), cB + kstep, voffB); PG8_STAGE(PG8_SA(1, 0), cA + kstep, voffA); PG8_STAGE(PG8_SB(1, 1), cB + hstep + kstep, voffB);
        PG8_WAIT_V(6); PG8_BAR;
    }
    for (;;) {
        const bool has_next = S.next(ui + 1, nxt);
        const char* nA = has_next ? (const char*)gA + (size_t)nxt.pm * tstepA + S.aoff(nxt) : cA; const char* nB = has_next ? (const char*)gB + (size_t)nxt.pn * tstep : cB;
        for (int t = 0; t < nt; t += 2) {
            const bool last = (t == nt - 2);
            const char* a1 = cA + (size_t)(t + 1) * kstep;
            const char* a2 = last ? nA : cA + (size_t)(t + 2) * kstep; const char* b2 = last ? nB : cB + (size_t)(t + 2) * kstep;
            const char* a3 = a2 + kstep; const char* b3 = b2 + kstep;
            if (last && has_next) S.a_ready(nxt);
            if constexpr (SP2) {
            PG8_LDB(B0, 0, 0); PG8_LDB(B1, 0, 1); PG8_SCHED; PG8_LDA(At, 0, 0); PG8_STAGE(PG8_SA(1, 1), a1 + hstepA, voffA);
            PG8_WAIT_V(8); PG8_WAIT_L(0); PG8_BAR; PG8_MMA(0, 0, At, B0); PG8_MMA(0, 1, At, B1); PG8_BAR; PG8_SCHED;
            PG8_LDA(At, 0, 1); PG8_STAGE(PG8_SB(0, 0), b2, voffB); PG8_STAGE(PG8_SB(0, 1), b2 + hstep, voffB); PG8_STAGE(PG8_SA(0, 0), a2, voffA);
            PG8_WAIT_V(8); PG8_WAIT_L(0); PG8_BAR; PG8_MMA(1, 0, At, B0); PG8_MMA(1, 1, At, B1); PG8_BAR; PG8_SCHED;
            PG8_LDB(B0, 1, 0); PG8_LDB(B1, 1, 1); PG8_SCHED; PG8_LDA(At, 1, 0); PG8_STAGE(PG8_SA(0, 1), a2 + hstepA, voffA);
            PG8_WAIT_V(8); PG8_WAIT_L(0); PG8_BAR; PG8_MMA(0, 0, At, B0); PG8_MMA(0, 1, At, B1); PG8_BAR; PG8_SCHED;
            PG8_LDA(At, 1, 1); PG8_STAGE(PG8_SB(1, 0), b3, voffB); PG8_STAGE(PG8_SB(1, 1), b3 + hstep, voffB); PG8_STAGE(PG8_SA(1, 0), a3, voffA);
            PG8_WAIT_V(8); PG8_WAIT_L(0); PG8_BAR; PG8_MMA(1, 0, At, B0); PG8_MMA(1, 1, At, B1); PG8_BAR; PG8_SCHED;
            } else {
            PG8_LDB(B0, 0, 0); PG8_SCHED; PG8_LDA(At, 0, 0); PG8_STAGE(PG8_SA(1, 1), a1 + hstepA, voffA);
            PG8_WAIT_L(8); PG8_BAR; PG8_WAIT_L(0); PG8_MMA(0, 0, At, B0); PG8_BAR; PG8_SCHED;
            PG8_LDB(B1, 0, 1); PG8_STAGE(PG8_SB(0, 0), b2, voffB);
            PG8_BAR; PG8_WAIT_L(0); PG8_MMA(0, 1, At, B1); PG8_BAR;
            PG8_LDA(At, 0, 1); PG8_STAGE(PG8_SA(0, 0), a2, voffA);
            PG8_BAR; PG8_WAIT_L(0); PG8_MMA(1, 0, At, B0); PG8_BAR; PG8_SCHED;
            PG8_STAGE(PG8_SB(0, 1), b2 + hstep, voffB);
            PG8_WAIT_V(6); PG8_BAR; PG8_MMA(1, 1, At, B1); PG8_BAR;
            PG8_LDB(B0, 1, 0); PG8_SCHED; PG8_LDA(At, 1, 0); PG8_STAGE(PG8_SA(0, 1), a2 + hstepA, voffA);
            PG8_WAIT_L(8); PG8_BAR; PG8_WAIT_L(0); PG8_MMA(0, 0, At, B0); PG8_BAR; PG8_SCHED;
            PG8_LDB(B1, 1, 1); PG8_STAGE(PG8_SB(1, 0), b3, voffB);
            PG8_BAR; PG8_WAIT_L(0); PG8_MMA(0, 1, At, B1); PG8_BAR;
            PG8_LDA(At, 1, 1); PG8_STAGE(PG8_SA(1, 0), a3, voffA);
            PG8_BAR; PG8_WAIT_L(0); PG8_MMA(1, 0, At, B0); PG8_BAR; PG8_SCHED;
            PG8_STAGE(PG8_SB(1, 1), b3 + hstep, voffB);
            PG8_WAIT_V(6); PG8_BAR; PG8_MMA(1, 1, At, B1); PG8_BAR;
            }
        }
        if constexpr (ALIGN_EPI) { if (wr == 0) PG8_BAR; }
        if constexpr (!Epi::AFTER_DRAIN) { E(acc, cur, wr, wc, fr, fq); S.done(cur); }
        if (!has_next) break;
#pragma unroll
        for (int a = 0; a < 2; ++a)
#pragma unroll
            for (int b = 0; b < 2; ++b)
#pragma unroll
                for (int m = 0; m < 4; ++m)
#pragma unroll
                    for (int n = 0; n < 2; ++n) acc[a][b][m][n] = (f32x4){0.f, 0.f, 0.f, 0.f};
        cur = nxt; cA = nA; cB = nB; ++ui; nt = S.nt(cur, K / BK);
        if constexpr (ALIGN_EPI) { if (wr == 1) PG8_BAR; }
    }
    PG8_WAIT_V(0);
    if constexpr (!ALIGN_EPI) { if (wr == 0) PG8_BAR; }
    PG8_BAR;
    if constexpr (Epi::AFTER_DRAIN) { E.fused(acc, cur, wr, wc, fr, fq, lds, wid, lane); S.done(cur); }
#undef PG8_SA
#undef PG8_SB
#undef PG8_STAGE
#undef PG8_LDA
#undef PG8_LDB
#undef PG8_MMA
#undef PG8_WAIT_V
#undef PG8_WAIT_L
#undef PG8_BAR
#undef PG8_SCHED
}
}

#define GAS __attribute__((address_space(1)))
#define LAS __attribute__((address_space(3)))
typedef unsigned short bf16;
typedef unsigned v4u __attribute__((ext_vector_type(4)));
typedef unsigned v2u __attribute__((ext_vector_type(2)));
typedef float f32x4 __attribute__((ext_vector_type(4)));
typedef short bf16x8 __attribute__((ext_vector_type(8)));
typedef short s16x4 __attribute__((ext_vector_type(4)));

constexpr int NB = 8, SEQ = 4096, DM = 1024, MTOK = NB * SEQ;
constexpr int ZC = 4864;
constexpr int QA = 0, KA = 768, VA = 1536, XB = 2304, GB = 2816, QC = 3328, KC = 3840, VC = 4352;
constexpr int INC = 7936, FFN = 2816, OC = 1280;
constexpr float NEGF = -1e30f;
constexpr size_t MiB = 1u << 20;
constexpr size_t WS_CTL = 0, CTL_BYTES = 2u << 20;
constexpr size_t WS_KM = 256 * 1024;
constexpr size_t WS_LC = 1 * MiB;
constexpr size_t WS_LF = 1 * MiB + 512 * 1024;
constexpr size_t WS_TABC = 2 * MiB;
constexpr size_t WS_TABA = 2 * MiB + 128 * 1024;
constexpr size_t WS_W = 4 * MiB;
constexpr size_t W_IN = 0, W_PA = W_IN + (size_t)INC * 1024 * 2, W_PB = W_PA + 1024 * 512 * 2, W_PC = W_PB + 1024 * 512 * 2,
                 W_OUT = W_PC + 1024 * 512 * 2, W_GU = W_OUT + 1024 * 1024 * 2, W_DOWN = W_GU + (size_t)5632 * 1024 * 2,
                 W_LA = W_DOWN + (size_t)1024 * 2816 * 2, W_LX = W_LA + 8 * 64 * 64 * 2, W_END = W_LX + 8 * 64 * 64 * 2;
static_assert(W_END <= 40 * MiB, "weights");
constexpr size_t WS_H = 44 * MiB;
constexpr size_t WS_O = 108 * MiB;
constexpr size_t WS_Z = 188 * MiB;
constexpr size_t WS_TMP3 = WS_Z;
constexpr size_t WS_MF = WS_Z + 192 * MiB;
constexpr size_t WS_FFH = WS_Z;
constexpr size_t WS_W2 = 492 * MiB;
constexpr size_t W2_LA = (size_t)INC * 1024 * 2, W2_LX = W2_LA + 8 * 64 * 64 * 2;
static_assert(WS_W2 + W2_LX + 8 * 64 * 64 * 2 <= 508 * MiB, "second W_in copy");
constexpr size_t WS_END = 508 * MiB;
__device__ __forceinline__ unsigned char* win_ptr(unsigned char* ws, int l) { return l == 0 ? ws + WS_W + W_IN : ws + WS_W2; }
__device__ __forceinline__ unsigned char* wla_ptr(unsigned char* ws, int l) { return l == 0 ? ws + WS_W + W_LA : ws + WS_W2 + W2_LA; }
__device__ __forceinline__ unsigned char* wlx_ptr(unsigned char* ws, int l) { return l == 0 ? ws + WS_W + W_LX : ws + WS_W2 + W2_LX; }

constexpr int LDS_BYTES = 163840;
constexpr int PW_IN = 16 * 248, PW_ALL = PW_IN + 4 * 32 + 8 * 32 + 8 * 32 + 16 * 32 + 16 * 176 + 44 * 32, PW_END = PW_ALL + 32;

__device__ __forceinline__ unsigned f2bf(float f) { unsigned u = __builtin_bit_cast(unsigned, f); return (u + 0x7fffu + ((u >> 16) & 1u)) >> 16; }
typedef float f32x2_t __attribute__((ext_vector_type(2))); typedef __bf16 bf16x2_t __attribute__((ext_vector_type(2)));
__device__ __forceinline__ unsigned pk2(float lo, float hi) { f32x2_t v = {lo, hi}; bf16x2_t b = __builtin_convertvector(v, bf16x2_t); return __builtin_bit_cast(unsigned, b); }
__device__ __forceinline__ float bflo(unsigned w) { return __uint_as_float(w << 16); }
__device__ __forceinline__ float bfhi(unsigned w) { return __uint_as_float(w & 0xffff0000u); }
__device__ __forceinline__ float bf2f(bf16 b) { return __uint_as_float((unsigned)b << 16); }
__device__ __forceinline__ float sigmoidf_(float x) { return __builtin_amdgcn_rcpf(1.0f + __expf(-x)); }
__device__ __forceinline__ bf16 f2bf_hw(float x) { return (bf16)(pk2(x, x) & 0xffffu); }
__device__ __forceinline__ float wave_sum(float v) {
#pragma unroll
    for (int o = 1; o < 64; o <<= 1) v += __shfl_xor(v, o);
    return v;
}
__device__ __forceinline__ f32x4 mfma16(bf16x8 a, bf16x8 b, f32x4 c) { return __builtin_amdgcn_mfma_f32_16x16x32_bf16(a, b, c, 0, 0, 0); }
__device__ __forceinline__ s16x4 vtr(const LAS unsigned char* p) { return __builtin_bit_cast(s16x4, __builtin_amdgcn_ds_read_tr16_b64_v4i16((LAS s16x4*)p)); }

#define TO_GLOBAL(T, p) ((T)(GAS void*)(p))
struct Params { const float* in[19]; float* out; unsigned char* ws; };

struct Ctx {
    LAS unsigned char* lds;
    int tid, lane, wave;
    const float* relb;
    unsigned char* ws;
};

__device__ __forceinline__ void transpose_item(const float* W, int K, int N, bf16* WT, int k0, int n0, int drow0, LAS float* scr, int lane, int ldw) {
    { size_t z = 0; asm volatile("" : "+s"(z)); W += z; WT += z; }
    float tw[32];
#pragma unroll
    for (int i = 0; i < 32; ++i) tw[i] = W[(size_t)(k0 + 2 * i + (lane >> 5)) * N + n0 + (lane & 31)];
#pragma unroll
    for (int i = 0; i < 32; ++i) scr[(2 * i + (lane >> 5)) * 33 + (lane & 31)] = tw[i];
    asm volatile("s_waitcnt lgkmcnt(0)" ::: "memory");
    const int c = lane & 7;
#pragma unroll
    for (int j = 0; j < 4; ++j) { const int n = (lane >> 3) + 8 * j; const LAS float* s = scr + (8 * c) * 33 + n;
        v4u o; o.x = pk2(s[0 * 33], s[1 * 33]); o.y = pk2(s[2 * 33], s[3 * 33]); o.z = pk2(s[4 * 33], s[5 * 33]); o.w = pk2(s[6 * 33], s[7 * 33]);
        *(v4u*)(WT + (size_t)(drow0 + n) * ldw + k0 + 8 * c) = o; }
    asm volatile("s_waitcnt lgkmcnt(0)" ::: "memory");
}
__device__ __forceinline__ bool tr_mat(int& r, const float* W, int K, int N, bf16* WT, LAS float* scr, int lane, bool gu, int ldw = 0) {
    const int nkb = K / 64, nnb = N / 32, cnt = nkb * nnb;
    if (r >= cnt) { r -= cnt; return false; }
    const int kb = r / nnb, nb = r % nnb, n0 = nb * 32;
    int drow = n0;
    if (gu) { drow = (n0 < FFN) ? (n0 / 128) * 256 + (n0 % 128) : ((n0 - FFN) / 128) * 256 + 128 + ((n0 - FFN) % 128); }
    transpose_item(W, K, N, WT, kb * 64, n0, drow, scr, lane, ldw ? ldw : K);
    return true;
}
template <int NR>
__device__ __forceinline__ void rms_rows_bf16(const float* x, const float* g, bf16* o, int m0, int mstride, int lane) {
    { size_t z = 0; asm volatile("" : "+s"(z)); g += z; }
    const f32x4* gr = (const f32x4*)g + lane;
    f32x4 v[NR][4];
#pragma unroll
    for (int k = 0; k < NR; ++k) { const f32x4* xr = (const f32x4*)(x + (size_t)(m0 + k * mstride) * DM) + lane;
#pragma unroll
        for (int j = 0; j < 4; ++j) v[k][j] = xr[64 * j]; }
    f32x4 gg[4];
#pragma unroll
    for (int j = 0; j < 4; ++j) gg[j] = gr[64 * j];
#pragma unroll
    for (int k = 0; k < NR; ++k) { float s = 0.f;
#pragma unroll
        for (int j = 0; j < 4; ++j) s += (v[k][j].x * v[k][j].x + v[k][j].y * v[k][j].y) + (v[k][j].z * v[k][j].z + v[k][j].w * v[k][j].w);
        const float rs = __builtin_amdgcn_rsqf(wave_sum(s) * (1.f / DM) + 1e-6f);
        v2u* o8 = (v2u*)(o + (size_t)(m0 + k * mstride) * DM) + lane;
#pragma unroll
        for (int j = 0; j < 4; ++j) { v2u w; w.x = pk2(v[k][j].x * rs * gg[j].x, v[k][j].y * rs * gg[j].y); w.y = pk2(v[k][j].z * rs * gg[j].z, v[k][j].w * rs * gg[j].w); o8[64 * j] = w; } }
}
template <int NR>
__device__ __forceinline__ void rms_rows_f32(float* x, const float* g, int m0, int mstride, int lane) {
    { size_t z = 0; asm volatile("" : "+s"(z)); g += z; }
    const f32x4* gr = (const f32x4*)g + lane;
    f32x4 v[NR][4];
#pragma unroll
    for (int k = 0; k < NR; ++k) { const f32x4* xr = (const f32x4*)(x + (size_t)(m0 + k * mstride) * DM) + lane;
#pragma unroll
        for (int j = 0; j < 4; ++j) v[k][j] = xr[64 * j]; }
    f32x4 gg[4];
#pragma unroll
    for (int j = 0; j < 4; ++j) gg[j] = gr[64 * j];
#pragma unroll
    for (int k = 0; k < NR; ++k) { float s = 0.f;
#pragma unroll
        for (int j = 0; j < 4; ++j) s += (v[k][j].x * v[k][j].x + v[k][j].y * v[k][j].y) + (v[k][j].z * v[k][j].z + v[k][j].w * v[k][j].w);
        const float rs = __builtin_amdgcn_rsqf(wave_sum(s) * (1.f / DM) + 1e-6f);
        f32x4* xr = (f32x4*)(x + (size_t)(m0 + k * mstride) * DM) + lane;
#pragma unroll
        for (int j = 0; j < 4; ++j) xr[64 * j] = v[k][j] * rs * gg[j]; }
}
__device__ __forceinline__ int rel_bucket_dev(int d) {
    if (d < 16) return d;
    const float df = (float)d;
    int large = 16 + (int)(logf(df / 16.0f) / 4.852030263919617f * 16.0f);
    return large < 31 ? large : 31;
}

__device__ __forceinline__ void prep_weights(const Ctx& C, const Params& p, int l, int gw, int NGW, int lo, int hi) {
    LAS float* scr = (LAS float*)(C.lds + C.wave * 16384);
    unsigned char* wb = C.ws + WS_W;
    for (int it = lo + gw; it < hi; it += NGW) {
        int r = it;
        if (tr_mat(r, p.in[3] + (size_t)l * 1024 * INC, 1024, INC, (bf16*)win_ptr(C.ws, l), scr, C.lane, false)) continue;
        if (tr_mat(r, p.in[11] + (size_t)l * 256 * 1024, 256, 1024, (bf16*)(wb + W_PA), scr, C.lane, false, 512)) continue;
        if (tr_mat(r, p.in[12] + (size_t)l * 512 * 1024, 512, 1024, (bf16*)(wb + W_PB), scr, C.lane, false)) continue;
        if (tr_mat(r, p.in[13] + (size_t)l * 512 * 1024, 512, 1024, (bf16*)(wb + W_PC), scr, C.lane, false)) continue;
        if (tr_mat(r, p.in[14] + (size_t)l * 1024 * 1024, 1024, 1024, (bf16*)(wb + W_OUT), scr, C.lane, false)) continue;
        if (tr_mat(r, p.in[16] + (size_t)l * 1024 * 5632, 1024, 5632, (bf16*)(wb + W_GU), scr, C.lane, true)) continue;
        if (tr_mat(r, p.in[17] + (size_t)l * 2816 * 1024, 2816, 1024, (bf16*)(wb + W_DOWN), scr, C.lane, false)) continue;
        { const int which = r / 16, rr = r % 16, mat = rr / 2, nb = rr % 2;
          const float* W = p.in[which ? 8 : 6] + (size_t)l * 8 * 4096 + mat * 4096;
          bf16* WT = (bf16*)(which ? wlx_ptr(C.ws, l) : wla_ptr(C.ws, l)) + mat * 4096;
          transpose_item(W, 64, 64, WT, 0, nb * 32, nb * 32, scr, C.lane, 64); }
    }
}

using pg8::Unit;
using pg8::cvt_pk_bf16;
struct EpiZ {
    static constexpr bool PERM = true, AFTER_DRAIN = false;
    bf16* O; float* KM;
    __device__ __forceinline__ void operator()(const f32x4 (&acc)[2][2][4][2], const Unit& u, int wr, int wc, int fr, int fq) const {
        const int row0 = u.pm * 256 + wr * 64 + fr, col0 = u.pn * 256 + wc * 32 + 8 * fq;
#pragma unroll
        for (int ai = 0; ai < 2; ++ai)
#pragma unroll
            for (int m = 0; m < 4; ++m) { bf16* rowp = O + (size_t)(row0 + ai * 128 + m * 16) * ZC + col0;
#pragma unroll
                for (int bj = 0; bj < 2; ++bj) { const f32x4 v0 = acc[ai][bj][m][0], v1 = acc[ai][bj][m][1]; v4u w;
                    w.x = cvt_pk_bf16(v0[0], v0[1]); w.y = cvt_pk_bf16(v0[2], v0[3]); w.z = cvt_pk_bf16(v1[0], v1[1]); w.w = cvt_pk_bf16(v1[2], v1[3]);
                    *(v4u*)(rowp + bj * 128) = w; } }
        if (u.pn == 15 || u.pn == 16) {
#pragma unroll
            for (int bj = 0; bj < 2; ++bj)
#pragma unroll
                for (int n = 0; n < 2; ++n) {
                    f32x4 s = (f32x4){0.f, 0.f, 0.f, 0.f};
#pragma unroll
                    for (int ai = 0; ai < 2; ++ai)
#pragma unroll
                        for (int m = 0; m < 4; ++m) s += acc[ai][bj][m][n];
#pragma unroll
                    for (int j = 0; j < 4; ++j) { float t = s[j]; t += __shfl_xor(t, 1); t += __shfl_xor(t, 2); t += __shfl_xor(t, 4); t += __shfl_xor(t, 8); s[j] = t; }
                    if (fr == 0) { float* d = KM + (size_t)u.pm * 512 + (col0 - KC) + bj * 128 + 4 * n;
#pragma unroll
                        for (int j = 0; j < 4; ++j) atomicAdd(d + j, s[j]); }
                }
        }
    }
};
struct EpiResid {
    static constexpr bool PERM = true, AFTER_DRAIN = false;
    const float* base; float* out;
    __device__ __forceinline__ void operator()(const f32x4 (&acc)[2][2][4][2], const Unit& u, int wr, int wc, int fr, int fq) const {
        const int row0 = u.pm * 256 + wr * 64 + fr, col0 = u.pn * 256 + wc * 32 + 8 * fq;
#pragma unroll
        for (int ai = 0; ai < 2; ++ai) {
            f32x4 bv[4][2][2];
#pragma unroll
            for (int m = 0; m < 4; ++m)
#pragma unroll
                for (int bj = 0; bj < 2; ++bj) { const float* bp = base + (size_t)(row0 + ai * 128 + m * 16) * DM + col0 + bj * 128; bv[m][bj][0] = *(const f32x4*)bp; bv[m][bj][1] = *(const f32x4*)(bp + 4); }
            asm volatile("" ::: "memory");
#pragma unroll
            for (int m = 0; m < 4; ++m)
#pragma unroll
                for (int bj = 0; bj < 2; ++bj) { float* op = out + (size_t)(row0 + ai * 128 + m * 16) * DM + col0 + bj * 128;
                    *(f32x4*)op = bv[m][bj][0] + acc[ai][bj][m][0]; *(f32x4*)(op + 4) = bv[m][bj][1] + acc[ai][bj][m][1]; }
            asm volatile("" ::: "memory");
        }
    }
};
struct EpiSwiGLU {
    static constexpr bool PERM = true, AFTER_DRAIN = false;
    bf16* O;
    __device__ __forceinline__ void operator()(const f32x4 (&acc)[2][2][4][2], const Unit& u, int wr, int wc, int fr, int fq) const {
        const int row0 = u.pm * 256 + wr * 64 + fr, col0 = u.pn * 128 + wc * 32 + 8 * fq;
#pragma unroll
        for (int ai = 0; ai < 2; ++ai)
#pragma unroll
            for (int m = 0; m < 4; ++m) { bf16* rowp = O + (size_t)(row0 + ai * 128 + m * 16) * FFN + col0;
                float r[8];
#pragma unroll
                for (int n = 0; n < 2; ++n)
#pragma unroll
                    for (int j = 0; j < 4; ++j) { const float g = acc[ai][0][m][n][j], up = acc[ai][1][m][n][j]; r[4 * n + j] = g * sigmoidf_(g) * up; }
                v4u w; w.x = cvt_pk_bf16(r[0], r[1]); w.y = cvt_pk_bf16(r[2], r[3]); w.z = cvt_pk_bf16(r[4], r[5]); w.w = cvt_pk_bf16(r[6], r[7]);
                *(v4u*)rowp = w; }
    }
};

struct GateOrder {
    pg8::StaticOrder T;
    __device__ void init(int G, int c) { T.init(MTOK, DM, G, c); }
    __device__ bool next(int i, Unit& u) const { Unit t; if (!T.next(i / 3, t)) return false; u.pm = t.pm; u.pn = (i % 3) * 4 + t.pn; return true; }
    __device__ __forceinline__ void a_ready(const Unit&) const {}
    __device__ __forceinline__ void done(const Unit&) const {}
    __device__ __forceinline__ size_t aoff(const Unit&) const { return 0; }
    __device__ __forceinline__ int nt(const Unit&, int d) const { return d; }
};
struct ProdOrder : GateOrder {
    __device__ __forceinline__ size_t aoff(const Unit& u) const { const int br = u.pn >> 2; return (size_t)(br == 0 ? 0 : (br == 1 ? 256 : 768)) * 2; }
    __device__ __forceinline__ int nt(const Unit& u, int) const { return (u.pn >> 2) == 0 ? 4 : 8; }
};
struct EpiTmp3 {
    static constexpr bool PERM = true, AFTER_DRAIN = false;
    bf16* O;
    __device__ __forceinline__ void operator()(const f32x4 (&acc)[2][2][4][2], const Unit& u, int wr, int wc, int fr, int fq) const {
        const int row0 = u.pm * 256 + wr * 64 + fr, col0 = u.pn * 256 + wc * 32 + 8 * fq;
#pragma unroll
        for (int ai = 0; ai < 2; ++ai)
#pragma unroll
            for (int m = 0; m < 4; ++m) { bf16* rowp = O + (size_t)(row0 + ai * 128 + m * 16) * 3072 + col0;
#pragma unroll
                for (int bj = 0; bj < 2; ++bj) { const f32x4 v0 = acc[ai][bj][m][0], v1 = acc[ai][bj][m][1]; v4u w;
                    w.x = cvt_pk_bf16(v0[0], v0[1]); w.y = cvt_pk_bf16(v0[2], v0[3]); w.z = cvt_pk_bf16(v1[0], v1[1]); w.w = cvt_pk_bf16(v1[2], v1[3]);
                    *(v4u*)(rowp + bj * 128) = w; } }
    }
};
struct EpiGate3 {
    static constexpr bool PERM = true, AFTER_DRAIN = false;
    bf16* T3;
    __device__ __forceinline__ void operator()(const f32x4 (&acc)[2][2][4][2], const Unit& u, int wr, int wc, int fr, int fq) const {
        const int br = u.pn >> 2, cn = u.pn & 3;
        const int row0 = u.pm * 256 + wr * 64 + fr, colm = cn * 256 + wc * 32 + 8 * fq, colt = u.pn * 256 + wc * 32 + 8 * fq;
#pragma unroll
        for (int ai = 0; ai < 2; ++ai) {
            v4u tv[4][2], av[4][2];
#pragma unroll
            for (int m = 0; m < 4; ++m)
#pragma unroll
                for (int bj = 0; bj < 2; ++bj) { const bf16* rp = T3 + (size_t)(row0 + ai * 128 + m * 16) * 3072 + bj * 128;
                    tv[m][bj] = *(const v4u*)(rp + colt); av[m][bj] = (br != 0) ? *(const v4u*)(rp + colm) : (v4u){0u, 0u, 0u, 0u}; }
            asm volatile("" ::: "memory");
#pragma unroll
            for (int m = 0; m < 4; ++m)
#pragma unroll
                for (int bj = 0; bj < 2; ++bj) { const f32x4 a0 = acc[ai][bj][m][0], a1 = acc[ai][bj][m][1]; const v4u t = tv[m][bj], o = av[m][bj];
                    v4u w;
                    w.x = cvt_pk_bf16(bflo(o.x) + sigmoidf_(a0[0]) * bflo(t.x), bfhi(o.x) + sigmoidf_(a0[1]) * bfhi(t.x));
                    w.y = cvt_pk_bf16(bflo(o.y) + sigmoidf_(a0[2]) * bflo(t.y), bfhi(o.y) + sigmoidf_(a0[3]) * bfhi(t.y));
                    w.z = cvt_pk_bf16(bflo(o.z) + sigmoidf_(a1[0]) * bflo(t.z), bfhi(o.z) + sigmoidf_(a1[1]) * bfhi(t.z));
                    w.w = cvt_pk_bf16(bflo(o.w) + sigmoidf_(a1[2]) * bflo(t.w), bfhi(o.w) + sigmoidf_(a1[3]) * bfhi(t.w));
                    *(v4u*)(T3 + (size_t)(row0 + ai * 128 + m * 16) * 3072 + bj * 128 + colm) = w; }
            asm volatile("" ::: "memory");
        }
    }
};

constexpr int AT_TAB = 0, AT_VST = 2176, AT_OG = 40960, AT_LSE = 40960 + 98304;
__device__ __forceinline__ void attnA_unit(const Ctx& C, int unit) {
#define SBAR() __builtin_amdgcn_sched_barrier(0)
    const int b = unit >> 6, j = (unit >> 4) & 3, T0 = (unit & 15) * 256;
    const GAS unsigned char* Zg = (const GAS unsigned char*)(C.ws + WS_Z) + (size_t)b * SEQ * ZC * 2;
    LAS float* biasT = (LAS float*)(C.lds + AT_TAB);
    LAS unsigned char* Vst = C.lds + AT_VST + C.wave * 4608;
    LAS bf16* OG = (LAS bf16*)(C.lds + AT_OG);
    LAS float* LSEl = (LAS float*)(C.lds + AT_LSE);
    const int lane = C.lane, i16 = lane & 15, g = lane >> 4;
    { const GAS float* TA = (const GAS float*)(C.ws + WS_TABA);
      for (int idx = C.tid; idx < 3 * 176; idx += 512) { const int grp = idx / 176, e = idx % 176 - 16; biasT[idx] = (e >= 0 && e <= 128) ? TA[(grp * 4 + j) * 132 + e] : 0.f; } }
    __syncthreads();
    const int L = i16 + 144 - 8 * g;
#pragma unroll 1
    for (int it = C.wave; it < 48; it += 8) {
        const int grp = it >> 4, k = it & 15;
        int dl, r, i0;
        if (grp == 0) { dl = 1; r = 0; i0 = T0 + 16 * k; } else if (grp == 1) { dl = 4; r = k & 3; i0 = (T0 >> 2) + 16 * (k >> 2); } else { dl = 16; r = k; i0 = T0 >> 4; }
        const int head = 4 * grp + j;
        const unsigned rstride = (unsigned)dl * (ZC * 2), rbase = (unsigned)r * (ZC * 2);
        const int tq = r + dl * (i0 + i16);
        const unsigned qoff = (unsigned)tq * (ZC * 2) + (QA + head * 64 + 8 * g) * 2;
        const bf16x8 q0 = *(const GAS bf16x8*)(Zg + qoff), q1 = *(const GAS bf16x8*)(Zg + qoff + 64);
        const int kbase = i0 - 144;
        const int klane = kbase + 8 * (i16 >> 2) + (i16 & 3);
        const unsigned kcol = rbase + (KA + head * 64 + 8 * g) * 2;
        bf16x8 kf[10][2];
#pragma unroll
        for (int kt = 0; kt < 10; ++kt) { int ks = klane + 32 * (kt >> 1) + 4 * (kt & 1); ks = ks < 0 ? 0 : ks;
            const unsigned off = (unsigned)ks * rstride + kcol; kf[kt][0] = *(const GAS bf16x8*)(Zg + off); kf[kt][1] = *(const GAS bf16x8*)(Zg + off + 64); }
        v4u vreg[5][4];
        { const int vl = kbase + (lane >> 3); const unsigned vcol = rbase + (VA + head * 64 + (lane & 7) * 8) * 2;
#pragma unroll
          for (int s5 = 0; s5 < 5; ++s5)
#pragma unroll
            for (int i = 0; i < 4; ++i) { int ks = vl + 32 * s5 + 8 * i; ks = ks < 0 ? 0 : ks; vreg[s5][i] = *(const GAS v4u*)(Zg + (unsigned)ks * rstride + vcol); } }
        SBAR();
        f32x4 S[10];
#pragma unroll
        for (int kt = 0; kt < 10; ++kt) { f32x4 a = mfma16(kf[kt][0], q0, (f32x4){0.f, 0.f, 0.f, 0.f}); S[kt] = mfma16(kf[kt][1], q1, a); }
        const LAS float* tb = biasT + grp * 176 + 16 + L - 159;
        const int kneg = kbase + 8 * g;
        const bool anyneg = kbase < 0;
        float tv[40];
#pragma unroll
        for (int kt = 0; kt < 10; ++kt)
#pragma unroll
            for (int jj = 0; jj < 4; ++jj) tv[4 * kt + jj] = tb[159 - (32 * (kt >> 1) + 4 * (kt & 1) + jj)];
        SBAR();
        float mx = NEGF;
#pragma unroll
        for (int kt = 0; kt < 10; ++kt)
#pragma unroll
            for (int jj = 0; jj < 4; ++jj) {
                const int c = 32 * (kt >> 1) + 4 * (kt & 1) + jj;
                float v = S[kt][jj] * 0.125f + tv[4 * kt + jj];
                if ((kt >> 1) == 0) v = (L - c <= 128) ? v : NEGF;
                if ((kt >> 1) == 4) v = (L - c >= 0) ? v : NEGF;
                S[kt][jj] = v;
            }
        if (anyneg) {
#pragma unroll
            for (int kt = 0; kt < 10; ++kt)
#pragma unroll
                for (int jj = 0; jj < 4; ++jj) { const int c = 32 * (kt >> 1) + 4 * (kt & 1) + jj; S[kt][jj] = (kneg + c >= 0) ? S[kt][jj] : NEGF; }
        }
#pragma unroll
        for (int kt = 0; kt < 10; ++kt)
#pragma unroll
            for (int jj = 0; jj < 4; ++jj) mx = fmaxf(mx, S[kt][jj]);
        mx = fmaxf(mx, __shfl_xor(mx, 16)); mx = fmaxf(mx, __shfl_xor(mx, 32));
        float sum = 0.f; const float mxl = mx * 1.4426950408889634f;
#pragma unroll
        for (int kt = 0; kt < 10; ++kt)
#pragma unroll
            for (int jj = 0; jj < 4; ++jj) { const float pv = __builtin_amdgcn_exp2f(S[kt][jj] * 1.4426950408889634f - mxl); S[kt][jj] = pv; sum += pv; }
        sum += __shfl_xor(sum, 16); sum += __shfl_xor(sum, 32);
        f32x4 O[4];
#pragma unroll
        for (int c = 0; c < 4; ++c) O[c] = (f32x4){0.f, 0.f, 0.f, 0.f};
        const LAS unsigned char* vrd = Vst + (8 * g + (i16 >> 2)) * 144 + 8 * (i16 & 3);
        LAS unsigned char* vwr = Vst + (lane >> 3) * 144 + (lane & 7) * 16;
#pragma unroll
        for (int s5 = 0; s5 < 5; ++s5) {
#pragma unroll
            for (int i = 0; i < 4; ++i) *(LAS v4u*)(vwr + 8 * i * 144) = vreg[s5][i];
            v4u pw; pw.x = pk2(S[2 * s5][0], S[2 * s5][1]); pw.y = pk2(S[2 * s5][2], S[2 * s5][3]); pw.z = pk2(S[2 * s5 + 1][0], S[2 * s5 + 1][1]); pw.w = pk2(S[2 * s5 + 1][2], S[2 * s5 + 1][3]);
            const bf16x8 pb = __builtin_bit_cast(bf16x8, pw);
            s16x4 vl[4][2];
#pragma unroll
            for (int c = 0; c < 4; ++c) { vl[c][0] = vtr(vrd + 32 * c); vl[c][1] = vtr(vrd + 32 * c + 4 * 144); }
            SBAR();
#pragma unroll
            for (int c = 0; c < 4; ++c) { const s16x4 lo = vl[c][0], hi = vl[c][1];
                const bf16x8 vf = (bf16x8){lo[0], lo[1], lo[2], lo[3], hi[0], hi[1], hi[2], hi[3]};
                O[c] = mfma16(vf, pb, O[c]); }
            SBAR();
        }
        const float inv = __builtin_amdgcn_rcpf(sum);
        LAS bf16* op = OG + (grp * 256 + (tq - T0)) * 64 + 4 * g;
#pragma unroll
        for (int c = 0; c < 4; ++c) { v2u w; w.x = pk2(O[c][0] * inv, O[c][1] * inv); w.y = pk2(O[c][2] * inv, O[c][3] * inv); *(LAS v2u*)(op + 16 * c) = w; }
        if (g == 0) LSEl[grp * 256 + (tq - T0)] = mx + __logf(sum);
    }
    __syncthreads();
    GAS bf16* Ob = (GAS bf16*)(C.ws + WS_O) + (size_t)b * SEQ * OC;
    for (int w = C.tid; w < 256 * 8; w += 512) {
        const int tl = w >> 3, tok = T0 + tl, ch = w & 7;
        const float l0 = LSEl[tl], l1 = LSEl[256 + tl], l2 = LSEl[512 + tl];
        const float mm = fmaxf(l0, fmaxf(l1, l2));
        float w0 = __expf(l0 - mm), w1 = __expf(l1 - mm), w2 = __expf(l2 - mm); const float iv = __builtin_amdgcn_rcpf(w0 + w1 + w2); w0 *= iv; w1 *= iv; w2 *= iv;
        const LAS bf16* zr = OG + tl * 64 + ch * 8;
        const v4u a = *(const LAS v4u*)zr, bq = *(const LAS v4u*)(zr + 256 * 64), c = *(const LAS v4u*)(zr + 512 * 64);
        v4u o;
        o.x = pk2(w0 * bflo(a.x) + w1 * bflo(bq.x) + w2 * bflo(c.x), w0 * bfhi(a.x) + w1 * bfhi(bq.x) + w2 * bfhi(c.x));
        o.y = pk2(w0 * bflo(a.y) + w1 * bflo(bq.y) + w2 * bflo(c.y), w0 * bfhi(a.y) + w1 * bfhi(bq.y) + w2 * bfhi(c.y));
        o.z = pk2(w0 * bflo(a.z) + w1 * bflo(bq.z) + w2 * bflo(c.z), w0 * bfhi(a.z) + w1 * bfhi(bq.z) + w2 * bfhi(c.z));
        o.w = pk2(w0 * bflo(a.w) + w1 * bflo(bq.w) + w2 * bflo(c.w), w0 * bfhi(a.w) + w1 * bfhi(bq.w) + w2 * bfhi(c.w));
        *(GAS v4u*)(Ob + (size_t)tok * OC + j * 64 + ch * 8) = o;
    }
    __syncthreads();
#undef SBAR
}

constexpr int MB_CNT = 64, MB_M = 1024, MB_L = 2048, MB_LIST = 3072, MB_TAB = 8192, MB_OST = 24576, MB_K = 90112, MB_V = 126976;
template <bool OWN>
__device__ __forceinline__ void moba_item(const bf16x8 q0, const bf16x8 q1, LAS unsigned char* lds, int lane, int qb, int n, int qid, bool valid, int smax) {
#define SBAR() __builtin_amdgcn_sched_barrier(0)
    const int i16 = lane & 15, g = lane >> 4;
    LAS float* Ost = (LAS float*)(lds + MB_OST); LAS float* mst = (LAS float*)(lds + MB_M); LAS float* lst = (LAS float*)(lds + MB_L);
    const LAS unsigned char* kbase = lds + MB_K + i16 * 144 + 16 * g;
    const LAS unsigned char* vbase = lds + MB_V + (4 * g + (i16 >> 2)) * 144 + 8 * (i16 & 3);
    f32x4 S[16];
#pragma unroll
    for (int sp = 0; sp < 4; ++sp) if (!OWN || 2 * sp <= smax) {
        bf16x8 kf[4][2];
#pragma unroll
        for (int t = 0; t < 4; ++t) { const LAS unsigned char* kp = kbase + (64 * sp + 32 * (t >> 1) + 16 * (t & 1)) * 144; kf[t][0] = *(const LAS bf16x8*)kp; kf[t][1] = *(const LAS bf16x8*)(kp + 64); }
        SBAR();
#pragma unroll
        for (int t = 0; t < 4; ++t) { f32x4 a = mfma16(kf[t][0], q0, (f32x4){0.f, 0.f, 0.f, 0.f}); S[4 * sp + t] = mfma16(kf[t][1], q1, a); }
        SBAR();
    }
    const float c2 = 0.125f * 1.4426950408889634f;
    const LAS float* tb = (const LAS float*)(lds + MB_TAB) + (256 * (qb - n) + qid - 4 * g - 255);
    float mx = NEGF;
#pragma unroll
    for (int sp = 0; sp < 4; ++sp) if (!OWN || 2 * sp <= smax) {
        float tv[16];
#pragma unroll
        for (int t = 0; t < 4; ++t)
#pragma unroll
            for (int jj = 0; jj < 4; ++jj) tv[4 * t + jj] = tb[255 - (64 * sp + 32 * (t >> 1) + 16 * (t & 1) + jj)];
        SBAR();
#pragma unroll
        for (int t = 0; t < 4; ++t)
#pragma unroll
            for (int jj = 0; jj < 4; ++jj) {
                float v = S[4 * sp + t][jj] * c2 + tv[4 * t + jj];
                if (OWN) { const int key = 64 * sp + 32 * (t >> 1) + 16 * (t & 1) + 4 * g + jj; v = (key <= qid) ? v : NEGF; }
                S[4 * sp + t][jj] = v; mx = fmaxf(mx, v);
            }
    }
    mx = fmaxf(mx, __shfl_xor(mx, 16)); mx = fmaxf(mx, __shfl_xor(mx, 32));
    float sum = 0.f;
#pragma unroll
    for (int sp = 0; sp < 4; ++sp) if (!OWN || 2 * sp <= smax) {
#pragma unroll
        for (int t = 0; t < 4; ++t)
#pragma unroll
            for (int jj = 0; jj < 4; ++jj) { const float pv = __builtin_amdgcn_exp2f(S[4 * sp + t][jj] - mx); S[4 * sp + t][jj] = pv; sum += pv; }
    }
    sum += __shfl_xor(sum, 16); sum += __shfl_xor(sum, 32);
    f32x4 O[4];
#pragma unroll
    for (int c = 0; c < 4; ++c) O[c] = (f32x4){0.f, 0.f, 0.f, 0.f};
#pragma unroll
    for (int s8 = 0; s8 < 8; ++s8) if (!OWN || (s8 >> 1) * 2 <= smax) {
        s16x4 vl[4][2];
#pragma unroll
        for (int c = 0; c < 4; ++c) { const LAS unsigned char* vp = vbase + (32 * s8) * 144 + 32 * c; vl[c][0] = vtr(vp); vl[c][1] = vtr(vp + 16 * 144); }
        const int t0 = 2 * s8; v4u pw; pw.x = pk2(S[t0][0], S[t0][1]); pw.y = pk2(S[t0][2], S[t0][3]); pw.z = pk2(S[t0 + 1][0], S[t0 + 1][1]); pw.w = pk2(S[t0 + 1][2], S[t0 + 1][3]);
        const bf16x8 pb = __builtin_bit_cast(bf16x8, pw);
        SBAR();
#pragma unroll
        for (int c = 0; c < 4; ++c) { const s16x4 lo = vl[c][0], hi = vl[c][1];
            const bf16x8 vf = (bf16x8){lo[0], lo[1], lo[2], lo[3], hi[0], hi[1], hi[2], hi[3]};
            O[c] = mfma16(vf, pb, O[c]); }
        SBAR();
    }
    if (valid) {
        LAS float* orow = Ost + qid * 64;
        if (OWN) {
#pragma unroll
            for (int c = 0; c < 4; ++c) *(LAS f32x4*)(orow + 4 * ((4 * c + g) ^ (qid & 15))) = O[c];
            if (g == 0) { mst[qid] = mx; lst[qid] = sum; }
        } else {
            const float mo = mst[qid], lo_ = lst[qid];
            f32x4 old[4];
#pragma unroll
            for (int c = 0; c < 4; ++c) old[c] = *(LAS f32x4*)(orow + 4 * ((4 * c + g) ^ (qid & 15)));
            const float mn = fmaxf(mo, mx), ao = __builtin_amdgcn_exp2f(mo - mn), ap = __builtin_amdgcn_exp2f(mx - mn);
#pragma unroll
            for (int c = 0; c < 4; ++c) *(LAS f32x4*)(orow + 4 * ((4 * c + g) ^ (qid & 15))) = old[c] * ao + O[c] * ap;
            if (g == 0) { mst[qid] = mn; lst[qid] = lo_ * ao + sum * ap; }
        }
    }
#undef SBAR
}
__device__ __forceinline__ void moba_unit(const Ctx& C, int unit, const float* KM) {
    const int qb = 15 - (unit >> 6), bh = unit & 63, b = bh >> 3, h = bh & 7;
    const bf16* Zb = (const bf16*)(C.ws + WS_Z) + (size_t)b * SEQ * ZC;
    LAS unsigned char* lds = C.lds - 64;
    LAS int* cnt = (LAS int*)(lds + MB_CNT);
    LAS unsigned char* lists = lds + MB_LIST;
    LAS float* tabC = (LAS float*)(lds + MB_TAB);
    LAS float* kml = (LAS float*)(lds + MB_K);
    const int lane = C.lane, i16 = lane & 15, tid = C.tid;
    const int ndist = 256 * qb + 256;
    {
        const float* TC = (const float*)(C.ws + WS_TABC) + h * 4096;
        float tv[8], kv[2]; v4u qv[8];
#pragma unroll
        for (int i = 0; i < 8; ++i) { const int d = tid + 512 * i; tv[i] = (d < ndist) ? TC[d] : 0.f; }
#pragma unroll
        for (int i = 0; i < 2; ++i) { const int e = tid + 512 * i; kv[i] = (e < qb * 64) ? KM[(size_t)(b * 16 + (e >> 6)) * 512 + h * 64 + (e & 63)] : 0.f; }
        if (tid < 256) { const bf16* qp = Zb + (size_t)(qb * 256 + tid) * ZC + QC + h * 64;
#pragma unroll
            for (int c = 0; c < 8; ++c) qv[c] = *(const v4u*)(qp + 8 * c); }
#pragma unroll
        for (int i = 0; i < 8; ++i) { const int d = tid + 512 * i; if (d < ndist) tabC[d] = tv[i]; }
#pragma unroll
        for (int i = 0; i < 2; ++i) { const int e = tid + 512 * i; if (e < qb * 64) kml[e] = kv[i] * (1.0f / 256.0f); }
        if (tid < 16) cnt[tid] = 0;
        __syncthreads();
        if (tid < 256) {
        float qf[64];
#pragma unroll
        for (int c = 0; c < 8; ++c) { const v4u w = qv[c];
            qf[8 * c + 0] = bflo(w.x); qf[8 * c + 1] = bfhi(w.x); qf[8 * c + 2] = bflo(w.y); qf[8 * c + 3] = bfhi(w.y);
            qf[8 * c + 4] = bflo(w.z); qf[8 * c + 5] = bfhi(w.z); qf[8 * c + 6] = bflo(w.w); qf[8 * c + 7] = bfhi(w.w); }
        float v1 = -3e38f, v2 = -3e38f, v3 = -3e38f; int i1 = -1, i2 = -1, i3 = -1;
        for (int n = 0; n < qb; ++n) {
            float s = 0.f;
#pragma unroll
            for (int e = 0; e < 64; ++e) s += qf[e] * kml[n * 64 + e];
            if (s > v1) { v3 = v2; i3 = i2; v2 = v1; i2 = i1; v1 = s; i1 = n; }
            else if (s > v2) { v3 = v2; i3 = i2; v2 = s; i2 = n; }
            else if (s > v3) { v3 = s; i3 = n; }
        }
        if (i1 >= 0) { const int pos = __hip_atomic_fetch_add(cnt + i1, 1, __ATOMIC_RELAXED, __HIP_MEMORY_SCOPE_WORKGROUP); lists[i1 * 256 + pos] = (unsigned char)tid; }
        if (i2 >= 0) { const int pos = __hip_atomic_fetch_add(cnt + i2, 1, __ATOMIC_RELAXED, __HIP_MEMORY_SCOPE_WORKGROUP); lists[i2 * 256 + pos] = (unsigned char)tid; }
        if (i3 >= 0) { const int pos = __hip_atomic_fetch_add(cnt + i3, 1, __ATOMIC_RELAXED, __HIP_MEMORY_SCOPE_WORKGROUP); lists[i3 * 256 + pos] = (unsigned char)tid; }
        }
    }
    v4u kreg[4], vreg[4];
#define MB_LOAD(nn) do { _Pragma("unroll") for (int i = 0; i < 4; ++i) { const int cidx = tid + 512 * i, row = cidx >> 3, ch = cidx & 7; \
        const bf16* src = Zb + (size_t)((nn) * 256 + row) * ZC + h * 64 + ch * 8; kreg[i] = *(const v4u*)(src + KC); vreg[i] = *(const v4u*)(src + VC); } } while (0)
#define MB_STORE() do { _Pragma("unroll") for (int i = 0; i < 4; ++i) { const int cidx = tid + 512 * i, row = cidx >> 3, ch = cidx & 7; \
        *(LAS v4u*)(lds + MB_K + row * 144 + ch * 16) = kreg[i]; *(LAS v4u*)(lds + MB_V + row * 144 + ch * 16) = vreg[i]; } } while (0)
#define MB_EXISTS(st, k) ((st) == 0 ? (k) < 2 : (C.wave + 8 * (k)) < ((cnt[(st) - 1] + 15) >> 4))
#define MB_QID(st, k, qid, valid) do { if ((st) == 0) { const int it_ = (k) ? 15 - C.wave : C.wave; qid = 16 * it_ + i16; valid = true; } \
        else { const int pos_ = 16 * (C.wave + 8 * (k)) + i16; valid = pos_ < cnt[(st) - 1]; qid = lists[((st) - 1) * 256 + (valid ? pos_ : 0)]; } } while (0)
#define MB_QLOAD(qid, d0, d1) do { const bf16* qp_ = Zb + (size_t)(qb * 256 + (qid)) * ZC + QC + h * 64 + 8 * (lane >> 4); d0 = *(const bf16x8*)qp_; d1 = *(const bf16x8*)(qp_ + 32); } while (0)
    MB_LOAD(qb);
    __syncthreads();
    for (int step = 0; step <= qb; ++step) {
        __syncthreads();
        MB_STORE();
        __syncthreads();
        if (step < qb) MB_LOAD(step);
#pragma unroll 1
        for (int k = 0; MB_EXISTS(step, k); ++k) {
            int cqid; bool cvalid; bf16x8 cq0, cq1;
            MB_QID(step, k, cqid, cvalid); MB_QLOAD(cqid, cq0, cq1);
            if (step == 0) { const int it = k ? 15 - C.wave : C.wave; moba_item<true>(cq0, cq1, lds, lane, qb, qb, cqid, true, (16 * it + 15) >> 5); }
            else moba_item<false>(cq0, cq1, lds, lane, qb, step - 1, cqid, cvalid, 7);
        }
    }
#undef MB_EXISTS
#undef MB_QID
#undef MB_QLOAD
#undef MB_LOAD
#undef MB_STORE
    __syncthreads();
    {
        const int qd = tid >> 1, hf = tid & 1;
        const LAS float* orow = (const LAS float*)(lds + MB_OST) + qd * 64; const float inv = __builtin_amdgcn_rcpf(((const LAS float*)(lds + MB_L))[qd]);
        bf16* op = (bf16*)(C.ws + WS_O) + (size_t)(b * SEQ + qb * 256 + qd) * OC + 768 + h * 64 + 32 * hf;
#pragma unroll
        for (int k = 0; k < 4; ++k) { const f32x4 a = *(const LAS f32x4*)(orow + 4 * ((8 * hf + 2 * k) ^ (qd & 15))), bq = *(const LAS f32x4*)(orow + 4 * ((8 * hf + 2 * k + 1) ^ (qd & 15)));
            v4u w; w.x = pk2(a[0] * inv, a[1] * inv); w.y = pk2(a[2] * inv, a[3] * inv); w.z = pk2(bq[0] * inv, bq[1] * inv); w.w = pk2(bq[2] * inv, bq[3] * inv);
            *(v4u*)(op + 8 * k) = w; }
    }
    __syncthreads();
}

__device__ __forceinline__ void lru_unit(const Ctx& C, const Params& p, int l, int unit) {
    const int tc = unit >> 6, b = (unit >> 3) & 7, nb = unit & 7, c0 = nb * 64;
    const bf16* Zb = (const bf16*)(C.ws + WS_Z) + (size_t)b * SEQ * ZC;
    bf16* Ob = (bf16*)(C.ws + WS_O) + (size_t)b * SEQ * OC;
    float* carr = (float*)(C.ws + WS_LC) + (size_t)(l * 1024) * 64;
    unsigned* flg = (unsigned*)(C.ws + WS_LF) + (size_t)(l * 1024) * 16;
    LAS unsigned char* XCB = C.lds;
    LAS float* RF = (LAS float*)(C.lds + 18432);
    LAS float* IF = (LAS float*)(C.lds + 18432 + 32768);
    LAS float* AGG = (LAS float*)(C.lds + 83968);
    LAS float* CAR = (LAS float*)(C.lds + 88064);
    LAS float* CARP = (LAS float*)(C.lds + 88320);
    LAS float* CIN = (LAS float*)(C.lds + 88576);
    LAS bf16* HL = (LAS bf16*)(C.lds + 90112);
    LAS bf16* PGL = (LAS bf16*)(C.lds + 122880);
    const int tid = C.tid, lane = C.lane, i16 = lane & 15, g = lane >> 4, c = tid & 63, tg = tid >> 6;
    const int ch = c0 + c;
    const float* cwp = p.in[4] + (size_t)l * 4 * 512;
    const float cw0 = cwp[ch], cw1 = cwp[512 + ch], cw2 = cwp[1024 + ch], cw3 = cwp[1536 + ch];
    const float cb = p.in[5][l * 512 + ch], ba = p.in[7][l * 512 + ch], bx = p.in[9][l * 512 + ch];
    const float lam = p.in[10][l * 512 + ch];
    const float logu = -8.0f * log1pf(expf(-lam));
    const bf16* WaT = (const bf16*)wla_ptr(C.ws, l) + nb * 4096;
    const bf16* WxT = (const bf16*)wlx_ptr(C.ws, l) + nb * 4096;
    bf16x8 wa[4][2], wx[4][2];
#pragma unroll
    for (int nt = 0; nt < 4; ++nt)
#pragma unroll
        for (int ks = 0; ks < 2; ++ks) { wa[nt][ks] = *(const bf16x8*)(WaT + (16 * nt + i16) * 64 + 32 * ks + 8 * g); wx[nt][ks] = *(const bf16x8*)(WxT + (16 * nt + i16) * 64 + 32 * ks + 8 * g); }
    if (tid < 64) { CAR[tid] = 0.f; CARP[tid] = 1.f; }
    __syncthreads();
#pragma unroll 1
    for (int tile = 0; tile < 2; ++tile) {
        const int tl0 = tile * 128 + 16 * tg, t0 = tc * 256 + tl0;
        float xw[19], gbv[16], xc[16];
#pragma unroll
        for (int k = 0; k < 19; ++k) { const int t = t0 - 3 + k; xw[k] = (t >= 0) ? bf2f(Zb[(size_t)t * ZC + XB + ch]) : 0.f; }
#pragma unroll
        for (int i = 0; i < 16; ++i) gbv[i] = bf2f(Zb[(size_t)(t0 + i) * ZC + GB + ch]);
#pragma unroll
        for (int i = 0; i < 16; ++i) { xc[i] = cb + cw0 * xw[i] + cw1 * xw[i + 1] + cw2 * xw[i + 2] + cw3 * xw[i + 3];
            *(LAS bf16*)(XCB + (16 * tg + i) * 144 + c * 2) = f2bf_hw(xc[i]); }
        __syncthreads();
        {
            const LAS unsigned char* ap = XCB + (16 * C.wave + i16) * 144 + 16 * g;
            const bf16x8 a0 = *(const LAS bf16x8*)ap, a1 = *(const LAS bf16x8*)(ap + 64);
#pragma unroll
            for (int nt = 0; nt < 4; ++nt) {
                f32x4 r = mfma16(a0, wa[nt][0], (f32x4){0.f, 0.f, 0.f, 0.f}); r = mfma16(a1, wa[nt][1], r);
                f32x4 x = mfma16(a0, wx[nt][0], (f32x4){0.f, 0.f, 0.f, 0.f}); x = mfma16(a1, wx[nt][1], x);
#pragma unroll
                for (int jj = 0; jj < 4; ++jj) { RF[(16 * C.wave + 4 * g + jj) * 64 + 16 * nt + i16] = r[jj]; IF[(16 * C.wave + 4 * g + jj) * 64 + 16 * nt + i16] = x[jj]; }
            }
        }
        __syncthreads();
        float av[16], bt[16]; float Ap = 1.f, hl = 0.f;
#pragma unroll
        for (int i = 0; i < 16; ++i) {
            const float r = sigmoidf_(RF[(16 * tg + i) * 64 + c] + ba), ig = sigmoidf_(IF[(16 * tg + i) * 64 + c] + bx);
            const float la = r * logu; av[i] = __expf(la);
            const float x2 = 2.0f * la;
            const float em = -x2 * (1.0f + x2 * (0.5f + x2 * (0.16666667f + x2 * (0.041666668f + x2 * (0.0083333338f + x2 * 0.0013888889f)))));
            bt[i] = __builtin_amdgcn_sqrtf(em) * (ig * xc[i]);
            Ap *= av[i]; hl = av[i] * hl + bt[i];
        }
        AGG[(tg * 64 + c) * 2] = Ap; AGG[(tg * 64 + c) * 2 + 1] = hl;
        __syncthreads();
        float hcur = CAR[c], pcur = CARP[c];
        for (int k = 0; k < tg; ++k) { const float ak = AGG[(k * 64 + c) * 2]; hcur = ak * hcur + AGG[(k * 64 + c) * 2 + 1]; pcur *= ak; }
#pragma unroll
        for (int i = 0; i < 16; ++i) {
            hcur = av[i] * hcur + bt[i]; pcur *= av[i];
            const float x = gbv[i], y = 0.7978845608028654f * (x + 0.044715f * x * x * x);
            const float th = 1.0f - 2.0f * __builtin_amdgcn_rcpf(__expf(2.0f * y) + 1.0f);
            const float ge = 0.5f * x * (1.0f + th);
            { const unsigned w2 = pk2(hcur * ge, pcur * ge); HL[(tl0 + i) * 64 + c] = (bf16)(w2 & 0xffffu); PGL[(tl0 + i) * 64 + c] = (bf16)(w2 >> 16); }
        }
        __syncthreads();
        if (tg == 7) { CAR[c] = hcur; CARP[c] = pcur; }
    }
    __syncthreads();
    if (tid < 64) {
        float cin = 0.f;
        if (tc > 0) {
            unsigned* pf = flg + (size_t)(unit - 64) * 16;
            while (__hip_atomic_load(pf, __ATOMIC_RELAXED, __HIP_MEMORY_SCOPE_AGENT) == 0u) __builtin_amdgcn_s_sleep(2);
            cin = __hip_atomic_load(carr + (size_t)(unit - 64) * 64 + tid, __ATOMIC_RELAXED, __HIP_MEMORY_SCOPE_AGENT);
        }
        CIN[tid] = cin;
        if (tc < 15) {
            __hip_atomic_store(carr + (size_t)unit * 64 + tid, CARP[tid] * cin + CAR[tid], __ATOMIC_RELAXED, __HIP_MEMORY_SCOPE_AGENT);
            asm volatile("s_waitcnt vmcnt(0)" ::: "memory");
            if (tid == 0) __hip_atomic_store(flg + (size_t)unit * 16, 1u, __ATOMIC_RELAXED, __HIP_MEMORY_SCOPE_AGENT);
        }
    }
    __syncthreads();
#pragma unroll
    for (int k = 0; k < 4; ++k) {
        const int w = tid + 512 * k, tl = w >> 3, cg8 = w & 7;
        const v4u hv = *(const LAS v4u*)(HL + tl * 64 + cg8 * 8), pv = *(const LAS v4u*)(PGL + tl * 64 + cg8 * 8);
        const f32x4 ci0 = *(const LAS f32x4*)(CIN + cg8 * 8), ci1 = *(const LAS f32x4*)(CIN + cg8 * 8 + 4);
        v4u o;
        o.x = pk2(bflo(hv.x) + bflo(pv.x) * ci0[0], bfhi(hv.x) + bfhi(pv.x) * ci0[1]);
        o.y = pk2(bflo(hv.y) + bflo(pv.y) * ci0[2], bfhi(hv.y) + bfhi(pv.y) * ci0[3]);
        o.z = pk2(bflo(hv.z) + bflo(pv.z) * ci1[0], bfhi(hv.z) + bfhi(pv.z) * ci1[1]);
        o.w = pk2(bflo(hv.w) + bflo(pv.w) * ci1[2], bfhi(hv.w) + bfhi(pv.w) * ci1[3]);
        *(v4u*)(Ob + (size_t)(tc * 256 + tl) * OC + 256 + c0 + cg8 * 8) = o;
    }
    __syncthreads();
}

#define XB_TMO      128
#define XB_XCNT(j)  (256  + 64 * (j))
#define XB_XSUB(j)  (1280 + 64 * (j))
#define XB_XGEN(j)  (2304 + 64 * (j))
#define XB_TOP      3328
#define XB_TOPGEN   3392
#define XCD_BAR_WORDS 3456
#define XB_SPIN_CAP (1u << 18)

__device__ __forceinline__ unsigned xb_ld(unsigned* p)              { return __hip_atomic_load(p, __ATOMIC_RELAXED, __HIP_MEMORY_SCOPE_AGENT); }
__device__ __forceinline__ unsigned xb_add(unsigned* p, unsigned v) { return __hip_atomic_fetch_add(p, v, __ATOMIC_RELAXED, __HIP_MEMORY_SCOPE_AGENT); }
__device__ __forceinline__ unsigned xb_xcc_id() { return (unsigned)__builtin_amdgcn_s_getreg((3 << 11) | 20) & 0xFu; }
#define XB_SPIN(cond, bar) do { unsigned _sp = 0; while (cond) { __builtin_amdgcn_s_sleep(1); \
    if ((++_sp & 255u) == 0u) { if (xb_ld(&(bar)[XB_TMO])) break; if (_sp > XB_SPIN_CAP) { atomicAdd(&(bar)[XB_TMO], 1u); break; } } } } while (0)

struct XcdBarrier {
    unsigned* bar; unsigned x;
    volatile LAS unsigned* st;
};

__device__ __forceinline__ XcdBarrier xcd_barrier_post(unsigned* bar, volatile LAS unsigned* st) {
    XcdBarrier b; b.bar = bar; b.x = xb_xcc_id(); b.st = st;
    if (threadIdx.x == 0) (void)xb_add(&bar[XB_XCNT(b.x)], 1u);
    return b;
}
__device__ __forceinline__ void xcd_barrier_complete(unsigned* bar, unsigned x, unsigned& nloc, unsigned& nx) {
    const unsigned G = gridDim.x * gridDim.y * gridDim.z;
    unsigned sum, cnt, mine, sp = 0u;
    for (;;) {
        sum = 0u; cnt = 0u; mine = 0u;
#pragma unroll
        for (unsigned j = 0; j < 16; ++j) { const unsigned c = xb_ld(&bar[XB_XCNT(j)]); sum += c; cnt += (c > 0u) ? 1u : 0u; mine = (j == x) ? c : mine; }
        if (sum == G) break;
        __builtin_amdgcn_s_sleep(1);
        if ((++sp & 255u) == 0u) { if (xb_ld(&bar[XB_TMO])) break; if (sp > XB_SPIN_CAP) { atomicAdd(&bar[XB_TMO], 1u); break; } }
    }
    nloc = mine > 0u ? mine : 1u; nx = cnt > 0u ? cnt : 1u;
}

__device__ __forceinline__ void xcd_barrier(const XcdBarrier& b) {
    asm volatile("s_waitcnt vmcnt(0)" ::: "memory");
    __syncthreads();
    if (threadIdx.x == 0) {
        unsigned* bar = b.bar;
        __builtin_amdgcn_s_waitcnt(0);
        unsigned nloc = b.st[0], nx = b.st[1];
        if (nloc == 0u) { xcd_barrier_complete(bar, b.x, nloc, nx); b.st[0] = nloc; b.st[1] = nx; }
        const unsigned old = xb_add(&bar[XB_XSUB(b.x)], 1u);
        const unsigned gen = old / nloc;
        if (old + 1u == (gen + 1u) * nloc) {
            __builtin_amdgcn_fence(__ATOMIC_RELEASE, "agent");
            asm volatile("s_waitcnt vmcnt(0)" ::: "memory");
            const unsigned og = xb_add(&bar[XB_TOP], 1u);
            const unsigned tg = og / nx;
            if (og + 1u == (tg + 1u) * nx) xb_add(&bar[XB_TOPGEN], 1u);
            else XB_SPIN(xb_ld(&bar[XB_TOPGEN]) == tg, bar);
            __builtin_amdgcn_fence(__ATOMIC_ACQUIRE, "agent");
            xb_add(&bar[XB_XGEN(b.x)], 1u);
            asm volatile("s_waitcnt vmcnt(0)" ::: "memory");
        } else {
            XB_SPIN(xb_ld(&bar[XB_XGEN(b.x)]) == gen, bar);
            __builtin_amdgcn_fence(__ATOMIC_ACQUIRE, "agent");
            asm volatile("s_waitcnt vmcnt(0)" ::: "memory");
        }
    }
    __syncthreads();
}

#define GSYNC() xcd_barrier(xbar)
#define MKCTX() Ctx C; size_t z_ = 0; { int t_ = threadIdx.x; asm volatile("" : "+s"(z_), "+v"(t_)); unsigned char* ws_ = p.ws + z_; const float* rb_ = p.in[1] + z_; \
    C.lds = (LAS unsigned char*)lds_raw + 64; C.tid = t_; C.lane = t_ & 63; C.wave = __builtin_amdgcn_readfirstlane(t_ >> 6); C.relb = rb_; C.ws = ws_; }
__global__ void __launch_bounds__(512) hybrid_fwd(Params p) {
    extern __shared__ __attribute__((aligned(16))) unsigned char lds_raw[];
    cg::grid_group grid = cg::this_grid();
    const int G = gridDim.x;
    if (threadIdx.x < 16) ((LAS unsigned*)lds_raw)[threadIdx.x] = 0u;
    __syncthreads();
    const XcdBarrier xbar = xcd_barrier_post((unsigned*)(p.ws + WS_CTL) + 16384, (volatile LAS unsigned*)((LAS unsigned char*)lds_raw + 16));
    volatile LAS int& s_unit = *(volatile LAS int*)(LAS unsigned char*)lds_raw;

#pragma nounroll
    for (int l = 0; l < 2; ++l) {
        { MKCTX(); const int gw = blockIdx.x * 8 + C.wave, NGW = G * 8;
          const float* xin = (l == 0) ? p.in[0] : p.out; xin += z_;
          bf16* Hb = (bf16*)(C.ws + WS_H);
          if (l == 0) { prep_weights(C, p, 0, gw, NGW, 0, PW_IN); prep_weights(C, p, 0, gw, NGW, PW_ALL, PW_END); }
          { int m = gw; for (; m + 3 * NGW < MTOK; m += 4 * NGW) rms_rows_bf16<4>(xin, p.in[2] + l * DM, Hb, m, NGW, C.lane); for (; m < MTOK; m += NGW) rms_rows_bf16<1>(xin, p.in[2] + l * DM, Hb, m, NGW, C.lane); }
          if (l == 0 && blockIdx.x < 8) { float* T = (float*)(C.ws + WS_TABC) + blockIdx.x * 4096; for (int d = C.tid; d < 4096; d += 512) T[d] = C.relb[rel_bucket_dev(d) * 20 + 12 + blockIdx.x] * 1.4426950408889634f; }
          if (l == 0 && blockIdx.x == 8) { float* T = (float*)(C.ws + WS_TABA); for (int idx = C.tid; idx < 12 * 132; idx += 512) { const int gj = idx / 132, dlt = idx % 132, grp = gj >> 2; T[idx] = C.relb[rel_bucket_dev((dlt > 128 ? 128 : dlt) << (2 * grp)) * 20 + gj]; } } }
        if (p.ws == nullptr) grid.sync();
        GSYNC();
#ifndef NO_P1
        { MKCTX(); pg8::Gemm gm{(const bf16*)(C.ws + WS_H), (const bf16*)win_ptr(C.ws, l), MTOK, ZC, 1024}; pg8::StaticOrder S; S.init(MTOK, ZC, G, (int)blockIdx.x);
          EpiZ E{(bf16*)(C.ws + WS_Z), (float*)(C.ws + WS_KM) + (size_t)l * 128 * 512};
          pg8::gemm_phase<EpiZ, pg8::StaticOrder, true, true>(C.lds, gm, S, E, 1024);
          { const int nwg = (MTOK / 256) * (ZC / 256), rounds = (nwg + G - 1) / G, rem = nwg - (rounds - 1) * G;
            const bool idle = rem < G; const int gwI = idle ? ((int)blockIdx.x - rem) * 8 + C.wave : (int)blockIdx.x * 8 + C.wave, ngwI = idle ? (G - rem) * 8 : G * 8;
            if (!idle || (int)blockIdx.x >= rem) { prep_weights(C, p, l, gwI, ngwI, PW_IN, PW_ALL);
                if (l == 0) { prep_weights(C, p, 1, gwI, ngwI, 0, PW_IN); prep_weights(C, p, 1, gwI, ngwI, PW_ALL, PW_END); } } } }
#endif
        GSYNC();
        for (;;) {
            MKCTX();
            unsigned* ctl = (unsigned*)(C.ws + WS_CTL);
            __syncthreads();
            if (C.tid == 0) s_unit = (int)atomicAdd(ctl + 64 * (1 + l), 1u);
            __syncthreads();
            const int u = s_unit;
            __syncthreads();
            if (u >= 1024 + 1024 + 512) break;
#ifndef NO_LRU
            if (u >= 1536) lru_unit(C, p, l, u - 1536);
#endif
#ifndef NO_MOBA
            if (u >= 512 && u < 1536) moba_unit(C, u - 512, (const float*)(C.ws + WS_KM) + (size_t)l * 128 * 512);
#endif
#ifndef NO_A
            if (u < 512) attnA_unit(C, u);
#endif
        }
        GSYNC();
#ifndef NO_P3
        { MKCTX(); ProdOrder S; S.init(G, (int)blockIdx.x);
          pg8::Gemm gm{(const bf16*)(C.ws + WS_O), (const bf16*)(C.ws + WS_W + W_PA), MTOK, 3072, 512}; EpiTmp3 E{(bf16*)(C.ws + WS_TMP3)};
          pg8::gemm_phase<EpiTmp3, ProdOrder, true, true>(C.lds, gm, S, E, OC);
        }
        { MKCTX(); GateOrder S; S.init(G, (int)blockIdx.x);
          pg8::Gemm gm{(const bf16*)(C.ws + WS_H), (const bf16*)win_ptr(C.ws, l) + (size_t)ZC * 1024, MTOK, 3072, 1024}; EpiGate3 E{(bf16*)(C.ws + WS_TMP3)};
          pg8::gemm_phase<EpiGate3, GateOrder, true, true>(C.lds, gm, S, E, 1024); }
#endif
        GSYNC();
#ifndef NO_P4
        { MKCTX(); pg8::Gemm gm{(const bf16*)(C.ws + WS_TMP3), (const bf16*)(C.ws + WS_W + W_OUT), MTOK, DM, 1024}; pg8::StaticOrder S; S.init(MTOK, DM, G, (int)blockIdx.x);
          const float* xin = (l == 0) ? p.in[0] : p.out; float* xo = p.out; xin += z_; xo += z_;
          EpiResid E{xin, xo};
          pg8::gemm_phase<EpiResid, pg8::StaticOrder, true, true>(C.lds, gm, S, E, 3072); }
#endif
        GSYNC();
        { MKCTX(); const int gw = blockIdx.x * 8 + C.wave, NGW = G * 8; float* xo = p.out + z_; bf16* Hb = (bf16*)(C.ws + WS_H);
          { int m = gw; for (; m + 3 * NGW < MTOK; m += 4 * NGW) rms_rows_bf16<4>(xo, p.in[15] + l * DM, Hb, m, NGW, C.lane); for (; m < MTOK; m += NGW) rms_rows_bf16<1>(xo, p.in[15] + l * DM, Hb, m, NGW, C.lane); } }
        GSYNC();
#ifndef NO_P6
        { MKCTX(); pg8::Gemm gm{(const bf16*)(C.ws + WS_H), (const bf16*)(C.ws + WS_W + W_GU), MTOK, 5632, 1024}; pg8::StaticOrder S; S.init(MTOK, 5632, G, (int)blockIdx.x);
          EpiSwiGLU E{(bf16*)(C.ws + WS_FFH)};
          pg8::gemm_phase<EpiSwiGLU, pg8::StaticOrder, true, true>(C.lds, gm, S, E, 1024);
        }
#endif
        GSYNC();
#ifndef NO_P7
        { MKCTX(); pg8::Gemm gm{(const bf16*)(C.ws + WS_FFH), (const bf16*)(C.ws + WS_W + W_DOWN), MTOK, DM, FFN}; pg8::StaticOrder S; S.init(MTOK, DM, G, (int)blockIdx.x);
          float* xo = p.out + z_;
          EpiResid E{xo, xo};
          pg8::gemm_phase<EpiResid, pg8::StaticOrder, true, true>(C.lds, gm, S, E, FFN); }
#endif
        GSYNC();
    }
    { MKCTX(); const int gw = blockIdx.x * 8 + C.wave, NGW = G * 8; float* xo = p.out + z_;
      { int m = gw; for (; m + 3 * NGW < MTOK; m += 4 * NGW) rms_rows_f32<4>(xo, p.in[18], m, NGW, C.lane); for (; m < MTOK; m += NGW) rms_rows_f32<1>(xo, p.in[18], m, NGW, C.lane); } }
}

extern "C" void kernel_launch(void* const* d_in, const int* in_sizes, int n_in, void* d_out, int out_size, void* d_ws, size_t ws_size, hipStream_t stream) {
    static int grid_blocks = 0;
    if (grid_blocks == 0) {
        if (n_in != 19 || out_size != MTOK * DM || ws_size < WS_END) { fprintf(stderr, "kernel_launch: unexpected shapes: n_in %d out %d ws %zu (need %zu)\n", n_in, out_size, ws_size, (size_t)WS_END); grid_blocks = -1; return; }
        int dev = 0, cus = 0, per_cu = 0;
        (void)hipGetDevice(&dev);
        (void)hipDeviceGetAttribute(&cus, hipDeviceAttributeMultiprocessorCount, dev);
        if (hipFuncSetAttribute((const void*)hybrid_fwd, hipFuncAttributeMaxDynamicSharedMemorySize, LDS_BYTES) != hipSuccess) { fprintf(stderr, "kernel_launch: hipFuncSetAttribute failed\n"); grid_blocks = -1; return; }
        if (hipOccupancyMaxActiveBlocksPerMultiprocessor(&per_cu, (const void*)hybrid_fwd, 512, LDS_BYTES) != hipSuccess || per_cu < 1) { fprintf(stderr, "kernel_launch: occupancy query gave %d\n", per_cu); per_cu = 1; }
        (void)hipGetLastError();
        grid_blocks = cus * per_cu;
        fprintf(stderr, "kernel_launch: grid %d (cus %d x %d)\n", grid_blocks, cus, per_cu);
    }
    if (grid_blocks < 0) return;
    (void)hipMemsetAsync((char*)d_ws + WS_CTL, 0, CTL_BYTES, stream);
    Params p{};
    for (int i = 0; i < 19; ++i) p.in[i] = (const float*)d_in[i];
    p.out = (float*)d_out; p.ws = (unsigned char*)d_ws;
    void* args[] = {&p};
    hipError_t e = hipLaunchCooperativeKernel((const void*)hybrid_fwd, dim3(grid_blocks), dim3(512), args, LDS_BYTES, stream);
    if (e != hipSuccess) fprintf(stderr, "cooperative launch failed: %s (grid %d)\n", hipGetErrorString(e), grid_blocks);
}
```

```cpp
#include <hip/hip_runtime.h>
#include <hip/hip_cooperative_groups.h>
#include <cstdio>
#include <cstdint>
namespace cg = cooperative_groups;
namespace pg8 {
#define PG8_LAS __attribute__((address_space(3)))
typedef unsigned short bf16_t;
typedef short bf16x8 __attribute__((ext_vector_type(8)));
typedef float f32x4 __attribute__((ext_vector_type(4)));
typedef unsigned u32x4 __attribute__((ext_vector_type(4)));
constexpr int BM = 256, BK = 64, HALF = 128, HTB = HALF * BK * 2  , STAGE_BYTES = 8 * HTB, NXCD = 8, WGM = 8;

__host__ __device__ __forceinline__ int lds_byte(int r, int c) { const int st = (r >> 4) * 2 + (c >> 5), rr = r & 15, cc = c & 31, ob = rr * 64 + cc * 2; return st * 1024 + (ob ^ (((ob >> 9) & 1) << 5)); }
__host__ __device__ __forceinline__ void stage_rc(int b, int& R, int& C) { const int st = b / 1024, sb = b % 1024, swz = sb ^ (((sb >> 9) & 1) << 5); R = (st >> 1) * 16 + swz / 64; C = (st & 1) * 32 + (swz % 64) / 2; }
__host__ __device__ __forceinline__ int perm32(int rho) { const int n = rho >> 4, i = rho & 15; return 8 * (i >> 2) + 4 * n + (i & 3); }

struct Unit { int pm, pn; };
struct Gemm { const bf16_t* A; const bf16_t* Bt; int M, N, K; };

struct StaticOrder {
    int nM, nN, nwg, G, c;
    __host__ __device__ void init(int M, int N, int G_, int c_) { nM = M / BM; nN = N / BM; nwg = nM * nN; G = G_; c = c_; }
    __host__ __device__ bool next(int i, Unit& u) const {
        const long L = (long)i * G + c; if (L >= nwg) return false;
        int wgid = (int)L; { const int q = nwg / NXCD, r = nwg % NXCD, xcd = wgid % NXCD, off = wgid / NXCD; wgid = (xcd < r ? xcd * (q + 1) : r * (q + 1) + (xcd - r) * q) + off; }
        const int nig = WGM * nN, gid = wgid / nig, fm = gid * WGM, gsz = (nM - fm) < WGM ? (nM - fm) : WGM;
        u.pm = fm + ((wgid % nig) % gsz); u.pn = (wgid % nig) / gsz; return true;
    }
    __device__ __forceinline__ void a_ready(const Unit&) const {}
    __device__ __forceinline__ void done(const Unit&) const {}
    __device__ __forceinline__ size_t aoff(const Unit&) const { return 0; }
    __device__ __forceinline__ int nt(const Unit&, int d) const { return d; }
};

__device__ __forceinline__ unsigned cvt_pk_bf16(float lo, float hi) { unsigned r; asm volatile("v_cvt_pk_bf16_f32 %0, %1, %2" : "=v"(r) : "v"(lo), "v"(hi)); return r; }
typedef float f32x2 __attribute__((ext_vector_type(2)));
__device__ __forceinline__ f32x2 gelu_pk(f32x2 v) {
    const f32x2 av = __builtin_elementwise_abs(v), d = av * 0.2316418882f + 1.0f;
    f32x2 t; t.x = __builtin_amdgcn_rcpf(d.x); t.y = __builtin_amdgcn_rcpf(d.y);
    f32x2 q = t * 0.5307027145f + (-0.7265760135f); q = q * t + 0.7107068705f; q = q * t + (-0.142248368f); q = q * t + 0.127414796f; q = q * t;
    const f32x2 s = (v * v) * (-0.72134752044f);
    f32x2 e; e.x = __builtin_amdgcn_exp2f(s.x); e.y = __builtin_amdgcn_exp2f(s.y);
    const f32x2 m = v * (q * e), r = v - m;
    f32x2 o; o.x = v.x < 0.f ? m.x : r.x; o.y = v.y < 0.f ? m.y : r.y; return o;
}

template <int ACT  > struct EpiBf16 {
    static constexpr bool PERM = true, AFTER_DRAIN = false; static_assert(ACT == 0 || ACT == 1, "EpiBf16: ACT is 0 (none) or 1 (gelu_pk)");
    bf16_t* O; int ldc; const float* bias; int split_cols; size_t split_stride; float scale0;
    __device__ __forceinline__ void operator()(const f32x4 (&acc)[2][2][4][2], const Unit& u, int wr, int wc, int fr, int fq) const {
        const int row0 = u.pm * BM + wr * 64 + fr; int colt = u.pn * BM; bf16_t* base = O;
        float sc = 1.f; if (split_cols) { const int t = colt / split_cols; base += (size_t)t * split_stride; colt -= t * split_cols; if (t == 0) sc = scale0; }
        const int col0 = colt + wc * 32 + 8 * fq, bcol0 = u.pn * BM + wc * 32 + 8 * fq;
        f32x4 bv[2][2];
#pragma unroll
        for (int bj = 0; bj < 2; ++bj)
#pragma unroll
            for (int n = 0; n < 2; ++n) bv[bj][n] = bias ? *(const f32x4*)(bias + bcol0 + bj * HALF + 4 * n) : (f32x4){0.f, 0.f, 0.f, 0.f};
#pragma unroll
        for (int ai = 0; ai < 2; ++ai)
#pragma unroll
            for (int m = 0; m < 4; ++m) { bf16_t* rowp = base + (size_t)(row0 + ai * HALF + m * 16) * ldc + col0;
#pragma unroll
                for (int bj = 0; bj < 2; ++bj) { f32x4 v0 = acc[ai][bj][m][0] + bv[bj][0], v1 = acc[ai][bj][m][1] + bv[bj][1];
                    if (ACT == 1) { f32x2 a = gelu_pk((f32x2){v0[0], v0[1]}), b = gelu_pk((f32x2){v0[2], v0[3]}), c = gelu_pk((f32x2){v1[0], v1[1]}), d = gelu_pk((f32x2){v1[2], v1[3]});
                        v0 = (f32x4){a.x, a.y, b.x, b.y}; v1 = (f32x4){c.x, c.y, d.x, d.y}; }
                    v0 = v0 * sc; v1 = v1 * sc; u32x4 w; w.x = cvt_pk_bf16(v0[0], v0[1]); w.y = cvt_pk_bf16(v0[2], v0[3]); w.z = cvt_pk_bf16(v1[0], v1[1]); w.w = cvt_pk_bf16(v1[2], v1[3]);
                    *(u32x4*)(rowp + bj * HALF) = w; } }
    }
};
template <class Epi, class Sched, bool ALIGN_EPI = false, bool SP2 = false>
__device__ __forceinline__ void gemm_phase(PG8_LAS unsigned char* lds, const Gemm g, const Sched& S, const Epi& E, const int lda) {
    int tid_ = threadIdx.x; const bf16_t* gA = g.A; const bf16_t* gB = g.Bt;
    asm volatile("" : "+v"(tid_), "+s"(gA), "+s"(gB));
    const int tid = tid_, wid = __builtin_amdgcn_readfirstlane(tid >> 6), lane = tid & 63, wr = wid >> 2, wc = wid & 3, fr = lane & 15, fq = lane >> 4;
    const int K = g.K; int nt = K / BK;
    unsigned voffA[2], voffB[2];
#pragma unroll
    for (int i = 0; i < 2; ++i) { int R, C; stage_rc(tid * 16 + i * 8192, R, C); const int Rb = Epi::PERM ? ((R & ~31) + perm32(R & 31)) : R;
        voffA[i] = (unsigned)(R * lda + C) * 2u; voffB[i] = (unsigned)(Rb * K + C) * 2u; }
    const size_t kstep = (size_t)(BK * 2);
    const size_t hstep = (size_t)HALF * K * 2, hstepA = (size_t)HALF * lda * 2;
    const size_t tstep = 2 * hstep, tstepA = 2 * hstepA;
    const unsigned ldsw = (unsigned)wid * 1024u;
    const int aoff = lds_byte(wr * 64 + fr, fq * 8), boff = lds_byte(wc * 32 + fr, fq * 8);
#define PG8_SA(b, h) (((b) * 2 + (h)) * HTB)
#define PG8_SB(b, h) ((4 + (b) * 2 + (h)) * HTB)
#define PG8_STAGE(bufoff, gbase, voff) do { _Pragma("unroll") for (int _i = 0; _i < 2; ++_i) \
        __builtin_amdgcn_global_load_lds((const unsigned*)((const char*)(gbase) + (voff)[_i]), (PG8_LAS unsigned*)(lds + (bufoff) + ldsw + _i * 8192), 16, 0, 0); } while (0)
#define PG8_LDA(dst, b, h) do { _Pragma("unroll") for (int m = 0; m < 4; ++m) _Pragma("unroll") for (int k = 0; k < 2; ++k) dst[m][k] = *(const PG8_LAS bf16x8*)(lds + PG8_SA(b, h) + aoff + m * 2048 + k * 1024); } while (0)
#define PG8_LDB(dst, b, h) do { _Pragma("unroll") for (int n = 0; n < 2; ++n) _Pragma("unroll") for (int k = 0; k < 2; ++k) dst[n][k] = *(const PG8_LAS bf16x8*)(lds + PG8_SB(b, h) + boff + n * 2048 + k * 1024); } while (0)
#define PG8_MMA(ai, bj, At, Bt) do { __builtin_amdgcn_s_setprio(1); _Pragma("unroll") for (int m = 0; m < 4; ++m) _Pragma("unroll") for (int n = 0; n < 2; ++n) _Pragma("unroll") for (int k = 0; k < 2; ++k) \
        acc[ai][bj][m][n] = __builtin_amdgcn_mfma_f32_16x16x32_bf16(Bt[n][k], At[m][k], acc[ai][bj][m][n], 0, 0, 0); __builtin_amdgcn_s_setprio(0); } while (0)
#define PG8_WAIT_V(n) asm volatile("s_waitcnt vmcnt(" #n ")" ::: "memory")
#define PG8_WAIT_L(n) asm volatile("s_waitcnt lgkmcnt(" #n ")" ::: "memory")
#define PG8_BAR __builtin_amdgcn_s_barrier()
#define PG8_SCHED __builtin_amdgcn_sched_barrier(0)
    Unit cur, nxt; int ui = 0;
    if (!S.next(0, cur)) return;
    f32x4 acc[2][2][4][2];
#pragma unroll
    for (int a = 0; a < 2; ++a)
#pragma unroll
        for (int b = 0; b < 2; ++b)
#pragma unroll
            for (int m = 0; m < 4; ++m)
#pragma unroll
                for (int n = 0; n < 2; ++n) acc[a][b][m][n] = (f32x4){0.f, 0.f, 0.f, 0.f};
    bf16x8 At[4][2], B0[2][2], B1[2][2];
    const char* cA = (const char*)gA + (size_t)cur.pm * tstepA + S.aoff(cur); const char* cB = (const char*)gB + (size_t)cur.pn * tstep;
    nt = S.nt(cur, K / BK);
    S.a_ready(cur);
    if constexpr (SP2) {
        PG8_STAGE(PG8_SB(0, 0), cB, voffB); PG8_STAGE(PG8_SB(0, 1), cB + hstep, voffB); PG8_STAGE(PG8_SA(0, 0), cA, voffA); PG8_STAGE(PG8_SA(0, 1), cA + hstepA, voffA);
        if (wr == 1) PG8_BAR;
        PG8_WAIT_V(2); PG8_BAR;
        PG8_STAGE(PG8_SB(1, 0), cB + kstep, voffB); PG8_STAGE(PG8_SA(1, 0), cA + kstep, voffA); PG8_STAGE(PG8_SB(1, 1), cB + hstep + kstep, voffB);
        PG8_WAIT_V(6); PG8_BAR;
    } else {
        PG8_STAGE(PG8_SB(0, 0), cB, voffB); PG8_STAGE(PG8_SA(0, 0), cA, voffA); PG8_STAGE(PG8_SB(0, 1), cB + hstep, voffB); PG8_STAGE(PG8_SA(0, 1), cA + hstepA, voffA);
        if (wr == 1) PG8_BAR;
        PG8_WAIT_V(4); PG8_BAR;
        PG8_STAGE(PG8_SB(1, 0), cB + kstep, voffB); PG8_STAGE(PG8_SA(1, 0), cA + kstep, voffA); PG8_STAGE(PG8_SB(1, 1), cB + hstep + kstep, voffB);
        PG8_WAIT_V(6); PG8_BAR;
    }
    for (;;) {
        const bool has_next = S.next(ui + 1, nxt);
        const char* nA = has_next ? (const char*)gA + (size_t)nxt.pm * tstepA + S.aoff(nxt) : cA; const char* nB = has_next ? (const char*)gB + (size_t)nxt.pn * tstep : cB;
        for (int t = 0; t < nt; t += 2) {
            const bool last = (t == nt - 2);
            const char* a1 = cA + (size_t)(t + 1) * kstep;
            const char* a2 = last ? nA : cA + (size_t)(t + 2) * kstep; const char* b2 = last ? nB : cB + (size_t)(t + 2) * kstep;
            const char* a3 = a2 + kstep; const char* b3 = b2 + kstep;
            if (last && has_next) S.a_ready(nxt);
            if constexpr (SP2) {
            PG8_LDB(B0, 0, 0); PG8_LDB(B1, 0, 1); PG8_SCHED; PG8_LDA(At, 0, 0); PG8_STAGE(PG8_SA(1, 1), a1 + hstepA, voffA);
            PG8_WAIT_V(8); PG8_WAIT_L(0); PG8_BAR; PG8_MMA(0, 0, At, B0); PG8_MMA(0, 1, At, B1); PG8_BAR; PG8_SCHED;
            PG8_LDA(At, 0, 1); PG8_STAGE(PG8_SB(0, 0), b2, voffB); PG8_STAGE(PG8_SB(0, 1), b2 + hstep, voffB); PG8_STAGE(PG8_SA(0, 0), a2, voffA);
            PG8_WAIT_V(8); PG8_WAIT_L(0); PG8_BAR; PG8_MMA(1, 0, At, B0); PG8_MMA(1, 1, At, B1); PG8_BAR; PG8_SCHED;
            PG8_LDB(B0, 1, 0); PG8_LDB(B1, 1, 1); PG8_SCHED; PG8_LDA(At, 1, 0); PG8_STAGE(PG8_SA(0, 1), a2 + hstepA, voffA);
            PG8_WAIT_V(8); PG8_WAIT_L(0); PG8_BAR; PG8_MMA(0, 0, At, B0); PG8_MMA(0, 1, At, B1); PG8_BAR; PG8_SCHED;
            PG8_LDA(At, 1, 1); PG8_STAGE(PG8_SB(1, 0), b3, voffB); PG8_STAGE(PG8_SB(1, 1), b3 + hstep, voffB); PG8_STAGE(PG8_SA(1, 0), a3, voffA);
            PG8_WAIT_V(8); PG8_WAIT_L(0); PG8_BAR; PG8_MMA(1, 0, At, B0); PG8_MMA(1, 1, At, B1); PG8_BAR; PG8_SCHED;
            } else {
            PG8_LDB(B0, 0, 0); PG8_SCHED; PG8_LDA(At, 0, 0); PG8_STAGE(PG8_SA(1, 1), a1 + hstepA, voffA);
            PG8_WAIT_L(8); PG8_BAR; PG8_WAIT_L(0); PG8_MMA(0, 0, At, B0); PG8_BAR; PG8_SCHED;
            PG8_LDB(B1, 0, 1); PG8_STAGE(PG8_SB(0, 0), b2, voffB);
            PG8_BAR; PG8_WAIT_L(0); PG8_MMA(0, 1, At, B1); PG8_BAR;
            PG8_LDA(At, 0, 1); PG8_STAGE(PG8_SA(0, 0), a2, voffA);
            PG8_BAR; PG8_WAIT_L(0); PG8_MMA(1, 0, At, B0); PG8_BAR; PG8_SCHED;
            PG8_STAGE(PG8_SB(0, 1), b2 + hstep, voffB);
            PG8_WAIT_V(6); PG8_BAR; PG8_MMA(1, 1, At, B1); PG8_BAR;
            PG8_LDB(B0, 1, 0); PG8_SCHED; PG8_LDA(At, 1, 0); PG8_STAGE(PG8_SA(0, 1), a2 + hstepA, voffA);
            PG8_WAIT_L(8); PG8_BAR; PG8_WAIT_L(0); PG8_MMA(0, 0, At, B0); PG8_BAR; PG8_SCHED;
            PG8_LDB(B1, 1, 1); PG8_STAGE(PG8_SB(1, 0), b3, voffB);
            PG8_BAR; PG8_WAIT_L(0); PG8_MMA(0, 1, At, B1); PG8_BAR;
            PG8_LDA(At, 1, 1); PG8_STAGE(PG8_SA(1, 0), a3, voffA);
            PG8_BAR; PG8_WAIT_L(0); PG8_MMA(1, 0, At, B0); PG8_BAR; PG8_SCHED;
            PG8_STAGE(PG8_SB(1, 1), b3 + hstep, voffB);
            PG8_WAIT_V(6); PG8_BAR; PG8_MMA(1, 1, At, B1); PG8_BAR;
            }
        }
        if constexpr (ALIGN_EPI) { if (wr == 0) PG8_BAR; }
        if constexpr (!Epi::AFTER_DRAIN) { E(acc, cur, wr, wc, fr, fq); S.done(cur); }
        if (!has_next) break;
#pragma unroll
        for (int a = 0; a < 2; ++a)
#pragma unroll
            for (int b = 0; b < 2; ++b)
#pragma unroll
                for (int m = 0; m < 4; ++m)
#pragma unroll
                    for (int n = 0; n < 2; ++n) acc[a][b][m][n] = (f32x4){0.f, 0.f, 0.f, 0.f};
        cur = nxt; cA = nA; cB = nB; ++ui; nt = S.nt(cur, K / BK);
        if constexpr (ALIGN_EPI) { if (wr == 1) PG8_BAR; }
    }
    PG8_WAIT_V(0);
    if constexpr (!ALIGN_EPI) { if (wr == 0) PG8_BAR; }
    PG8_BAR;
    if constexpr (Epi::AFTER_DRAIN) { E.fused(acc, cur, wr, wc, fr, fq, lds, wid, lane); S.done(cur); }
#undef PG8_SA
#undef PG8_SB
#undef PG8_STAGE
#undef PG8_LDA
#undef PG8_LDB
#undef PG8_MMA
#undef PG8_WAIT_V
#undef PG8_WAIT_L
#undef PG8_BAR
#undef PG8_SCHED
}
}

#define GAS __attribute__((address_space(1)))
#define LAS __attribute__((address_space(3)))
typedef unsigned short bf16;
typedef unsigned v4u __attribute__((ext_vector_type(4)));
typedef unsigned v2u __attribute__((ext_vector_type(2)));
typedef float f32x4 __attribute__((ext_vector_type(4)));
typedef short bf16x8 __attribute__((ext_vector_type(8)));
typedef short s16x4 __attribute__((ext_vector_type(4)));

constexpr int NB = 8, SEQ = 4096, DM = 1024, MTOK = NB * SEQ;
constexpr int ZC = 4864;
constexpr int QA = 0, KA = 768, VA = 1536, XB = 2304, GB = 2816, QC = 3328, KC = 3840, VC = 4352;
constexpr int INC = 7936, FFN = 2816, OC = 1280;
constexpr float NEGF = -1e30f;
constexpr size_t MiB = 1u << 20;
constexpr size_t WS_CTL = 0, CTL_BYTES = 2u << 20;
constexpr size_t WS_KM = 256 * 1024;
constexpr size_t WS_LC = 1 * MiB;
constexpr size_t WS_LF = 1 * MiB + 512 * 1024;
constexpr size_t WS_TABC = 2 * MiB;
constexpr size_t WS_TABA = 2 * MiB + 128 * 1024;
constexpr size_t WS_W = 4 * MiB;
constexpr size_t W_IN = 0, W_PA = W_IN + (size_t)INC * 1024 * 2, W_PB = W_PA + 1024 * 512 * 2, W_PC = W_PB + 1024 * 512 * 2,
                 W_OUT = W_PC + 1024 * 512 * 2, W_GU = W_OUT + 1024 * 1024 * 2, W_DOWN = W_GU + (size_t)5632 * 1024 * 2,
                 W_LA = W_DOWN + (size_t)1024 * 2816 * 2, W_LX = W_LA + 8 * 64 * 64 * 2, W_END = W_LX + 8 * 64 * 64 * 2;
static_assert(W_END <= 40 * MiB, "weights");
constexpr size_t WS_H = 44 * MiB;
constexpr size_t WS_O = 108 * MiB;
constexpr size_t WS_Z = 188 * MiB;
constexpr size_t WS_TMP3 = WS_Z;
constexpr size_t WS_MF = WS_Z + 192 * MiB;
constexpr size_t WS_FFH = WS_Z;
constexpr size_t WS_W2 = 492 * MiB;
constexpr size_t W2_LA = (size_t)INC * 1024 * 2, W2_LX = W2_LA + 8 * 64 * 64 * 2;
static_assert(WS_W2 + W2_LX + 8 * 64 * 64 * 2 <= 508 * MiB, "second W_in copy");
constexpr size_t WS_END = 508 * MiB;
__device__ __forceinline__ unsigned char* win_ptr(unsigned char* ws, int l) { return l == 0 ? ws + WS_W + W_IN : ws + WS_W2; }
__device__ __forceinline__ unsigned char* wla_ptr(unsigned char* ws, int l) { return l == 0 ? ws + WS_W + W_LA : ws + WS_W2 + W2_LA; }
__device__ __forceinline__ unsigned char* wlx_ptr(unsigned char* ws, int l) { return l == 0 ? ws + WS_W + W_LX : ws + WS_W2 + W2_LX; }

constexpr int LDS_BYTES = 163840;
constexpr int PW_IN = 16 * 248, PW_ALL = PW_IN + 4 * 32 + 8 * 32 + 8 * 32 + 16 * 32 + 16 * 176 + 44 * 32, PW_END = PW_ALL + 32;

__device__ __forceinline__ unsigned f2bf(float f) { unsigned u = __builtin_bit_cast(unsigned, f); return (u + 0x7fffu + ((u >> 16) & 1u)) >> 16; }
typedef float f32x2_t __attribute__((ext_vector_type(2))); typedef __bf16 bf16x2_t __attribute__((ext_vector_type(2)));
__device__ __forceinline__ unsigned pk2(float lo, float hi) { f32x2_t v = {lo, hi}; bf16x2_t b = __builtin_convertvector(v, bf16x2_t); return __builtin_bit_cast(unsigned, b); }
__device__ __forceinline__ float bflo(unsigned w) { return __uint_as_float(w << 16); }
__device__ __forceinline__ float bfhi(unsigned w) { return __uint_as_float(w & 0xffff0000u); }
__device__ __forceinline__ float bf2f(bf16 b) { return __uint_as_float((unsigned)b << 16); }
__device__ __forceinline__ float sigmoidf_(float x) { return __builtin_amdgcn_rcpf(1.0f + __expf(-x)); }
__device__ __forceinline__ bf16 f2bf_hw(float x) { return (bf16)(pk2(x, x) & 0xffffu); }
__device__ __forceinline__ float wave_sum(float v) {
#pragma unroll
    for (int o = 1; o < 64; o <<= 1) v += __shfl_xor(v, o);
    return v;
}
__device__ __forceinline__ f32x4 mfma16(bf16x8 a, bf16x8 b, f32x4 c) { return __builtin_amdgcn_mfma_f32_16x16x32_bf16(a, b, c, 0, 0, 0); }
__device__ __forceinline__ s16x4 vtr(const LAS unsigned char* p) { return __builtin_bit_cast(s16x4, __builtin_amdgcn_ds_read_tr16_b64_v4i16((LAS s16x4*)p)); }

#define TO_GLOBAL(T, p) ((T)(GAS void*)(p))
struct Params { const float* in[19]; float* out; unsigned char* ws; };

struct Ctx {
    LAS unsigned char* lds;
    int tid, lane, wave;
    const float* relb;
    unsigned char* ws;
};

__device__ __forceinline__ void transpose_item(const float* W, int K, int N, bf16* WT, int k0, int n0, int drow0, LAS float* scr, int lane, int ldw) {
    { size_t z = 0; asm volatile("" : "+s"(z)); W += z; WT += z; }
    float tw[32];
#pragma unroll
    for (int i = 0; i < 32; ++i) tw[i] = W[(size_t)(k0 + 2 * i + (lane >> 5)) * N + n0 + (lane & 31)];
#pragma unroll
    for (int i = 0; i < 32; ++i) scr[(2 * i + (lane >> 5)) * 33 + (lane & 31)] = tw[i];
    asm volatile("s_waitcnt lgkmcnt(0)" ::: "memory");
    const int c = lane & 7;
#pragma unroll
    for (int j = 0; j < 4; ++j) { const int n = (lane >> 3) + 8 * j; const LAS float* s = scr + (8 * c) * 33 + n;
        v4u o; o.x = pk2(s[0 * 33], s[1 * 33]); o.y = pk2(s[2 * 33], s[3 * 33]); o.z = pk2(s[4 * 33], s[5 * 33]); o.w = pk2(s[6 * 33], s[7 * 33]);
        *(v4u*)(WT + (size_t)(drow0 + n) * ldw + k0 + 8 * c) = o; }
    asm volatile("s_waitcnt lgkmcnt(0)" ::: "memory");
}
__device__ __forceinline__ bool tr_mat(int& r, const float* W, int K, int N, bf16* WT, LAS float* scr, int lane, bool gu, int ldw = 0) {
    const int nkb = K / 64, nnb = N / 32, cnt = nkb * nnb;
    if (r >= cnt) { r -= cnt; return false; }
    const int kb = r / nnb, nb = r % nnb, n0 = nb * 32;
    int drow = n0;
    if (gu) { drow = (n0 < FFN) ? (n0 / 128) * 256 + (n0 % 128) : ((n0 - FFN) / 128) * 256 + 128 + ((n0 - FFN) % 128); }
    transpose_item(W, K, N, WT, kb * 64, n0, drow, scr, lane, ldw ? ldw : K);
    return true;
}
template <int NR>
__device__ __forceinline__ void rms_rows_bf16(const float* x, const float* g, bf16* o, int m0, int mstride, int lane) {
    { size_t z = 0; asm volatile("" : "+s"(z)); g += z; }
    const f32x4* gr = (const f32x4*)g + lane;
    f32x4 v[NR][4];
#pragma unroll
    for (int k = 0; k < NR; ++k) { const f32x4* xr = (const f32x4*)(x + (size_t)(m0 + k * mstride) * DM) + lane;
#pragma unroll
        for (int j = 0; j < 4; ++j) v[k][j] = xr[64 * j]; }
    f32x4 gg[4];
#pragma unroll
    for (int j = 0; j < 4; ++j) gg[j] = gr[64 * j];
#pragma unroll
    for (int k = 0; k < NR; ++k) { float s = 0.f;
#pragma unroll
        for (int j = 0; j < 4; ++j) s += (v[k][j].x * v[k][j].x + v[k][j].y * v[k][j].y) + (v[k][j].z * v[k][j].z + v[k][j].w * v[k][j].w);
        const float rs = __builtin_amdgcn_rsqf(wave_sum(s) * (1.f / DM) + 1e-6f);
        v2u* o8 = (v2u*)(o + (size_t)(m0 + k * mstride) * DM) + lane;
#pragma unroll
        for (int j = 0; j < 4; ++j) { v2u w; w.x = pk2(v[k][j].x * rs * gg[j].x, v[k][j].y * rs * gg[j].y); w.y = pk2(v[k][j].z * rs * gg[j].z, v[k][j].w * rs * gg[j].w); o8[64 * j] = w; } }
}
template <int NR>
__device__ __forceinline__ void rms_rows_f32(float* x, const float* g, int m0, int mstride, int lane) {
    { size_t z = 0; asm volatile("" : "+s"(z)); g += z; }
    const f32x4* gr = (const f32x4*)g + lane;
    f32x4 v[NR][4];
#pragma unroll
    for (int k = 0; k < NR; ++k) { const f32x4* xr = (const f32x4*)(x + (size_t)(m0 + k * mstride) * DM) + lane;
#pragma unroll
        for (int j = 0; j < 4; ++j) v[k][j] = xr[64 * j]; }
    f32x4 gg[4];
#pragma unroll
    for (int j = 0; j < 4; ++j) gg[j] = gr[64 * j];
#pragma unroll
    for (int k = 0; k < NR; ++k) { float s = 0.f;
#pragma unroll
        for (int j = 0; j < 4; ++j) s += (v[k][j].x * v[k][j].x + v[k][j].y * v[k][j].y) + (v[k][j].z * v[k][j].z + v[k][j].w * v[k][j].w);
        const float rs = __builtin_amdgcn_rsqf(wave_sum(s) * (1.f / DM) + 1e-6f);
        f32x4* xr = (f32x4*)(x + (size_t)(m0 + k * mstride) * DM) + lane;
#pragma unroll
        for (int j = 0; j < 4; ++j) xr[64 * j] = v[k][j] * rs * gg[j]; }
}
__device__ __forceinline__ int rel_bucket_dev(int d) {
    if (d < 16) return d;
    const float df = (float)d;
    int large = 16 + (int)(logf(df / 16.0f) / 4.852030263919617f * 16.0f);
    return large < 31 ? large : 31;
}

__device__ __forceinline__ void prep_weights(const Ctx& C, const Params& p, int l, int gw, int NGW, int lo, int hi) {
    LAS float* scr = (LAS float*)(C.lds + C.wave * 16384);
    unsigned char* wb = C.ws + WS_W;
    for (int it = lo + gw; it < hi; it += NGW) {
        int r = it;
        if (tr_mat(r, p.in[3] + (size_t)l * 1024 * INC, 1024, INC, (bf16*)win_ptr(C.ws, l), scr, C.lane, false)) continue;
        if (tr_mat(r, p.in[11] + (size_t)l * 256 * 1024, 256, 1024, (bf16*)(wb + W_PA), scr, C.lane, false, 512)) continue;
        if (tr_mat(r, p.in[12] + (size_t)l * 512 * 1024, 512, 1024, (bf16*)(wb + W_PB), scr, C.lane, false)) continue;
        if (tr_mat(r, p.in[13] + (size_t)l * 512 * 1024, 512, 1024, (bf16*)(wb + W_PC), scr, C.lane, false)) continue;
        if (tr_mat(r, p.in[14] + (size_t)l * 1024 * 1024, 1024, 1024, (bf16*)(wb + W_OUT), scr, C.lane, false)) continue;
        if (tr_mat(r, p.in[16] + (size_t)l * 1024 * 5632, 1024, 5632, (bf16*)(wb + W_GU), scr, C.lane, true)) continue;
        if (tr_mat(r, p.in[17] + (size_t)l * 2816 * 1024, 2816, 1024, (bf16*)(wb + W_DOWN), scr, C.lane, false)) continue;
        { const int which = r / 16, rr = r % 16, mat = rr / 2, nb = rr % 2;
          const float* W = p.in[which ? 8 : 6] + (size_t)l * 8 * 4096 + mat * 4096;
          bf16* WT = (bf16*)(which ? wlx_ptr(C.ws, l) : wla_ptr(C.ws, l)) + mat * 4096;
          transpose_item(W, 64, 64, WT, 0, nb * 32, nb * 32, scr, C.lane, 64); }
    }
}

using pg8::Unit;
using pg8::cvt_pk_bf16;
struct EpiZ {
    static constexpr bool PERM = true, AFTER_DRAIN = false;
    bf16* O; float* KM;
    __device__ __forceinline__ void operator()(const f32x4 (&acc)[2][2][4][2], const Unit& u, int wr, int wc, int fr, int fq) const {
        const int row0 = u.pm * 256 + wr * 64 + fr, col0 = u.pn * 256 + wc * 32 + 8 * fq;
#pragma unroll
        for (int ai = 0; ai < 2; ++ai)
#pragma unroll
            for (int m = 0; m < 4; ++m) { bf16* rowp = O + (size_t)(row0 + ai * 128 + m * 16) * ZC + col0;
#pragma unroll
                for (int bj = 0; bj < 2; ++bj) { const f32x4 v0 = acc[ai][bj][m][0], v1 = acc[ai][bj][m][1]; v4u w;
                    w.x = cvt_pk_bf16(v0[0], v0[1]); w.y = cvt_pk_bf16(v0[2], v0[3]); w.z = cvt_pk_bf16(v1[0], v1[1]); w.w = cvt_pk_bf16(v1[2], v1[3]);
                    *(v4u*)(rowp + bj * 128) = w; } }
        if (u.pn == 15 || u.pn == 16) {
#pragma unroll
            for (int bj = 0; bj < 2; ++bj)
#pragma unroll
                for (int n = 0; n < 2; ++n) {
                    f32x4 s = (f32x4){0.f, 0.f, 0.f, 0.f};
#pragma unroll
                    for (int ai = 0; ai < 2; ++ai)
#pragma unroll
                        for (int m = 0; m < 4; ++m) s += acc[ai][bj][m][n];
#pragma unroll
                    for (int j = 0; j < 4; ++j) { float t = s[j]; t += __shfl_xor(t, 1); t += __shfl_xor(t, 2); t += __shfl_xor(t, 4); t += __shfl_xor(t, 8); s[j] = t; }
                    if (fr == 0) { float* d = KM + (size_t)u.pm * 512 + (col0 - KC) + bj * 128 + 4 * n;
#pragma unroll
                        for (int j = 0; j < 4; ++j) atomicAdd(d + j, s[j]); }
                }
        }
    }
};
struct EpiResid {
    static constexpr bool PERM = true, AFTER_DRAIN = false;
    const float* base; float* out;
    __device__ __forceinline__ void operator()(const f32x4 (&acc)[2][2][4][2], const Unit& u, int wr, int wc, int fr, int fq) const {
        const int row0 = u.pm * 256 + wr * 64 + fr, col0 = u.pn * 256 + wc * 32 + 8 * fq;
#pragma unroll
        for (int ai = 0; ai < 2; ++ai) {
            f32x4 bv[4][2][2];
#pragma unroll
            for (int m = 0; m < 4; ++m)
#pragma unroll
                for (int bj = 0; bj < 2; ++bj) { const float* bp = base + (size_t)(row0 + ai * 128 + m * 16) * DM + col0 + bj * 128; bv[m][bj][0] = *(const f32x4*)bp; bv[m][bj][1] = *(const f32x4*)(bp + 4); }
            asm volatile("" ::: "memory");
#pragma unroll
            for (int m = 0; m < 4; ++m)
#pragma unroll
                for (int bj = 0; bj < 2; ++bj) { float* op = out + (size_t)(row0 + ai * 128 + m * 16) * DM + col0 + bj * 128;
                    *(f32x4*)op = bv[m][bj][0] + acc[ai][bj][m][0]; *(f32x4*)(op + 4) = bv[m][bj][1] + acc[ai][bj][m][1]; }
            asm volatile("" ::: "memory");
        }
    }
};
struct EpiSwiGLU {
    static constexpr bool PERM = true, AFTER_DRAIN = false;
    bf16* O;
    __device__ __forceinline__ void operator()(const f32x4 (&acc)[2][2][4][2], const Unit& u, int wr, int wc, int fr, int fq) const {
        const int row0 = u.pm * 256 + wr * 64 + fr, col0 = u.pn * 128 + wc * 32 + 8 * fq;
#pragma unroll
        for (int ai = 0; ai < 2; ++ai)
#pragma unroll
            for (int m = 0; m < 4; ++m) { bf16* rowp = O + (size_t)(row0 + ai * 128 + m * 16) * FFN + col0;
                float r[8];
#pragma unroll
                for (int n = 0; n < 2; ++n)
#pragma unroll
                    for (int j = 0; j < 4; ++j) { const float g = acc[ai][0][m][n][j], up = acc[ai][1][m][n][j]; r[4 * n + j] = g * sigmoidf_(g) * up; }
                v4u w; w.x = cvt_pk_bf16(r[0], r[1]); w.y = cvt_pk_bf16(r[2], r[3]); w.z = cvt_pk_bf16(r[4], r[5]); w.w = cvt_pk_bf16(r[6], r[7]);
                *(v4u*)rowp = w; }
    }
};

struct GateOrder {
    pg8::StaticOrder T;
    __device__ void init(int G, int c) { T.init(MTOK, DM, G, c); }
    __device__ bool next(int i, Unit& u) const { Unit t; if (!T.next(i / 3, t)) return false; u.pm = t.pm; u.pn = (i % 3) * 4 + t.pn; return true; }
    __device__ __forceinline__ void a_ready(const Unit&) const {}
    __device__ __forceinline__ void done(const Unit&) const {}
    __device__ __forceinline__ size_t aoff(const Unit&) const { return 0; }
    __device__ __forceinline__ int nt(const Unit&, int d) const { return d; }
};
struct ProdOrder : GateOrder {
    __device__ __forceinline__ size_t aoff(const Unit& u) const { const int br = u.pn >> 2; return (size_t)(br == 0 ? 0 : (br == 1 ? 256 : 768)) * 2; }
    __device__ __forceinline__ int nt(const Unit& u, int) const { return (u.pn >> 2) == 0 ? 4 : 8; }
};
struct EpiTmp3 {
    static constexpr bool PERM = true, AFTER_DRAIN = false;
    bf16* O;
    __device__ __forceinline__ void operator()(const f32x4 (&acc)[2][2][4][2], const Unit& u, int wr, int wc, int fr, int fq) const {
        const int row0 = u.pm * 256 + wr * 64 + fr, col0 = u.pn * 256 + wc * 32 + 8 * fq;
#pragma unroll
        for (int ai = 0; ai < 2; ++ai)
#pragma unroll
            for (int m = 0; m < 4; ++m) { bf16* rowp = O + (size_t)(row0 + ai * 128 + m * 16) * 3072 + col0;
#pragma unroll
                for (int bj = 0; bj < 2; ++bj) { const f32x4 v0 = acc[ai][bj][m][0], v1 = acc[ai][bj][m][1]; v4u w;
                    w.x = cvt_pk_bf16(v0[0], v0[1]); w.y = cvt_pk_bf16(v0[2], v0[3]); w.z = cvt_pk_bf16(v1[0], v1[1]); w.w = cvt_pk_bf16(v1[2], v1[3]);
                    *(v4u*)(rowp + bj * 128) = w; } }
    }
};
struct EpiGate3 {
    static constexpr bool PERM = true, AFTER_DRAIN = false;
    bf16* T3;
    __device__ __forceinline__ void operator()(const f32x4 (&acc)[2][2][4][2], const Unit& u, int wr, int wc, int fr, int fq) const {
        const int br = u.pn >> 2, cn = u.pn & 3;
        const int row0 = u.pm * 256 + wr * 64 + fr, colm = cn * 256 + wc * 32 + 8 * fq, colt = u.pn * 256 + wc * 32 + 8 * fq;
#pragma unroll
        for (int ai = 0; ai < 2; ++ai) {
            v4u tv[4][2], av[4][2];
#pragma unroll
            for (int m = 0; m < 4; ++m)
#pragma unroll
                for (int bj = 0; bj < 2; ++bj) { const bf16* rp = T3 + (size_t)(row0 + ai * 128 + m * 16) * 3072 + bj * 128;
                    tv[m][bj] = *(const v4u*)(rp + colt); av[m][bj] = (br != 0) ? *(const v4u*)(rp + colm) : (v4u){0u, 0u, 0u, 0u}; }
            asm volatile("" ::: "memory");
#pragma unroll
            for (int m = 0; m < 4; ++m)
#pragma unroll
                for (int bj = 0; bj < 2; ++bj) { const f32x4 a0 = acc[ai][bj][m][0], a1 = acc[ai][bj][m][1]; const v4u t = tv[m][bj], o = av[m][bj];
                    v4u w;
                    w.x = cvt_pk_bf16(bflo(o.x) + sigmoidf_(a0[0]) * bflo(t.x), bfhi(o.x) + sigmoidf_(a0[1]) * bfhi(t.x));
                    w.y = cvt_pk_bf16(bflo(o.y) + sigmoidf_(a0[2]) * bflo(t.y), bfhi(o.y) + sigmoidf_(a0[3]) * bfhi(t.y));
                    w.z = cvt_pk_bf16(bflo(o.z) + sigmoidf_(a1[0]) * bflo(t.z), bfhi(o.z) + sigmoidf_(a1[1]) * bfhi(t.z));
                    w.w = cvt_pk_bf16(bflo(o.w) + sigmoidf_(a1[2]) * bflo(t.w), bfhi(o.w) + sigmoidf_(a1[3]) * bfhi(t.w));
                    *(v4u*)(T3 + (size_t)(row0 + ai * 128 + m * 16) * 3072 + bj * 128 + colm) = w; }
            asm volatile("" ::: "memory");
        }
    }
};

constexpr int AT_TAB = 0, AT_VST = 2176, AT_OG = 40960, AT_LSE = 40960 + 98304;
__device__ __forceinline__ void attnA_unit(const Ctx& C, int unit) {
#define SBAR() __builtin_amdgcn_sched_barrier(0)
    const int b = unit >> 6, j = (unit >> 4) & 3, T0 = (unit & 15) * 256;
    const GAS unsigned char* Zg = (const GAS unsigned char*)(C.ws + WS_Z) + (size_t)b * SEQ * ZC * 2;
    LAS float* biasT = (LAS float*)(C.lds + AT_TAB);
    LAS unsigned char* Vst = C.lds + AT_VST + C.wave * 4608;
    LAS bf16* OG = (LAS bf16*)(C.lds + AT_OG);
    LAS float* LSEl = (LAS float*)(C.lds + AT_LSE);
    const int lane = C.lane, i16 = lane & 15, g = lane >> 4;
    { const GAS float* TA = (const GAS float*)(C.ws + WS_TABA);
      for (int idx = C.tid; idx < 3 * 176; idx += 512) { const int grp = idx / 176, e = idx % 176 - 16; biasT[idx] = (e >= 0 && e <= 128) ? TA[(grp * 4 + j) * 132 + e] : 0.f; } }
    __syncthreads();
    const int L = i16 + 144 - 8 * g;
#pragma unroll 1
    for (int it = C.wave; it < 48; it += 8) {
        const int grp = it >> 4, k = it & 15;
        int dl, r, i0;
        if (grp == 0) { dl = 1; r = 0; i0 = T0 + 16 * k; } else if (grp == 1) { dl = 4; r = k & 3; i0 = (T0 >> 2) + 16 * (k >> 2); } else { dl = 16; r = k; i0 = T0 >> 4; }
        const int head = 4 * grp + j;
        const unsigned rstride = (unsigned)dl * (ZC * 2), rbase = (unsigned)r * (ZC * 2);
        const int tq = r + dl * (i0 + i16);
        const unsigned qoff = (unsigned)tq * (ZC * 2) + (QA + head * 64 + 8 * g) * 2;
        const bf16x8 q0 = *(const GAS bf16x8*)(Zg + qoff), q1 = *(const GAS bf16x8*)(Zg + qoff + 64);
        const int kbase = i0 - 144;
        const int klane = kbase + 8 * (i16 >> 2) + (i16 & 3);
        const unsigned kcol = rbase + (KA + head * 64 + 8 * g) * 2;
        bf16x8 kf[10][2];
#pragma unroll
        for (int kt = 0; kt < 10; ++kt) { int ks = klane + 32 * (kt >> 1) + 4 * (kt & 1); ks = ks < 0 ? 0 : ks;
            const unsigned off = (unsigned)ks * rstride + kcol; kf[kt][0] = *(const GAS bf16x8*)(Zg + off); kf[kt][1] = *(const GAS bf16x8*)(Zg + off + 64); }
        v4u vreg[5][4];
        { const int vl = kbase + (lane >> 3); const unsigned vcol = rbase + (VA + head * 64 + (lane & 7) * 8) * 2;
#pragma unroll
          for (int s5 = 0; s5 < 5; ++s5)
#pragma unroll
            for (int i = 0; i < 4; ++i) { int ks = vl + 32 * s5 + 8 * i; ks = ks < 0 ? 0 : ks; vreg[s5][i] = *(const GAS v4u*)(Zg + (unsigned)ks * rstride + vcol); } }
        SBAR();
        f32x4 S[10];
#pragma unroll
        for (int kt = 0; kt < 10; ++kt) { f32x4 a = mfma16(kf[kt][0], q0, (f32x4){0.f, 0.f, 0.f, 0.f}); S[kt] = mfma16(kf[kt][1], q1, a); }
        const LAS float* tb = biasT + grp * 176 + 16 + L - 159;
        const int kneg = kbase + 8 * g;
        const bool anyneg = kbase < 0;
        float tv[40];
#pragma unroll
        for (int kt = 0; kt < 10; ++kt)
#pragma unroll
            for (int jj = 0; jj < 4; ++jj) tv[4 * kt + jj] = tb[159 - (32 * (kt >> 1) + 4 * (kt & 1) + jj)];
        SBAR();
        float mx = NEGF;
#pragma unroll
        for (int kt = 0; kt < 10; ++kt)
#pragma unroll
            for (int jj = 0; jj < 4; ++jj) {
                const int c = 32 * (kt >> 1) + 4 * (kt & 1) + jj;
                float v = S[kt][jj] * 0.125f + tv[4 * kt + jj];
                if ((kt >> 1) == 0) v = (L - c <= 128) ? v : NEGF;
                if ((kt >> 1) == 4) v = (L - c >= 0) ? v : NEGF;
                S[kt][jj] = v;
            }
        if (anyneg) {
#pragma unroll
            for (int kt = 0; kt < 10; ++kt)
#pragma unroll
                for (int jj = 0; jj < 4; ++jj) { const int c = 32 * (kt >> 1) + 4 * (kt & 1) + jj; S[kt][jj] = (kneg + c >= 0) ? S[kt][jj] : NEGF; }
        }
#pragma unroll
        for (int kt = 0; kt < 10; ++kt)
#pragma unroll
            for (int jj = 0; jj < 4; ++jj) mx = fmaxf(mx, S[kt][jj]);
        mx = fmaxf(mx, __shfl_xor(mx, 16)); mx = fmaxf(mx, __shfl_xor(mx, 32));
        float sum = 0.f; const float mxl = mx * 1.4426950408889634f;
#pragma unroll
        for (int kt = 0; kt < 10; ++kt)
#pragma unroll
            for (int jj = 0; jj < 4; ++jj) { const float pv = __builtin_amdgcn_exp2f(S[kt][jj] * 1.4426950408889634f - mxl); S[kt][jj] = pv; sum += pv; }
        sum += __shfl_xor(sum, 16); sum += __shfl_xor(sum, 32);
        f32x4 O[4];
#pragma unroll
        for (int c = 0; c < 4; ++c) O[c] = (f32x4){0.f, 0.f, 0.f, 0.f};
        const LAS unsigned char* vrd = Vst + (8 * g + (i16 >> 2)) * 144 + 8 * (i16 & 3);
        LAS unsigned char* vwr = Vst + (lane >> 3) * 144 + (lane & 7) * 16;
#pragma unroll
        for (int s5 = 0; s5 < 5; ++s5) {
#pragma unroll
            for (int i = 0; i < 4; ++i) *(LAS v4u*)(vwr + 8 * i * 144) = vreg[s5][i];
            v4u pw; pw.x = pk2(S[2 * s5][0], S[2 * s5][1]); pw.y = pk2(S[2 * s5][2], S[2 * s5][3]); pw.z = pk2(S[2 * s5 + 1][0], S[2 * s5 + 1][1]); pw.w = pk2(S[2 * s5 + 1][2], S[2 * s5 + 1][3]);
            const bf16x8 pb = __builtin_bit_cast(bf16x8, pw);
            s16x4 vl[4][2];
#pragma unroll
            for (int c = 0; c < 4; ++c) { vl[c][0] = vtr(vrd + 32 * c); vl[c][1] = vtr(vrd + 32 * c + 4 * 144); }
            SBAR();
#pragma unroll
            for (int c = 0; c < 4; ++c) { const s16x4 lo = vl[c][0], hi = vl[c][1];
                const bf16x8 vf = (bf16x8){lo[0], lo[1], lo[2], lo[3], hi[0], hi[1], hi[2], hi[3]};
                O[c] = mfma16(vf, pb, O[c]); }
            SBAR();
        }
        const float inv = __builtin_amdgcn_rcpf(sum);
        LAS bf16* op = OG + (grp * 256 + (tq - T0)) * 64 + 4 * g;
#pragma unroll
        for (int c = 0; c < 4; ++c) { v2u w; w.x = pk2(O[c][0] * inv, O[c][1] * inv); w.y = pk2(O[c][2] * inv, O[c][3] * inv); *(LAS v2u*)(op + 16 * c) = w; }
        if (g == 0) LSEl[grp * 256 + (tq - T0)] = mx + __logf(sum);
    }
    __syncthreads();
    GAS bf16* Ob = (GAS bf16*)(C.ws + WS_O) + (size_t)b * SEQ * OC;
    for (int w = C.tid; w < 256 * 8; w += 512) {
        const int tl = w >> 3, tok = T0 + tl, ch = w & 7;
        const float l0 = LSEl[tl], l1 = LSEl[256 + tl], l2 = LSEl[512 + tl];
        const float mm = fmaxf(l0, fmaxf(l1, l2));
        float w0 = __expf(l0 - mm), w1 = __expf(l1 - mm), w2 = __expf(l2 - mm); const float iv = __builtin_amdgcn_rcpf(w0 + w1 + w2); w0 *= iv; w1 *= iv; w2 *= iv;
        const LAS bf16* zr = OG + tl * 64 + ch * 8;
        const v4u a = *(const LAS v4u*)zr, bq = *(const LAS v4u*)(zr + 256 * 64), c = *(const LAS v4u*)(zr + 512 * 64);
        v4u o;
        o.x = pk2(w0 * bflo(a.x) + w1 * bflo(bq.x) + w2 * bflo(c.x), w0 * bfhi(a.x) + w1 * bfhi(bq.x) + w2 * bfhi(c.x));
        o.y = pk2(w0 * bflo(a.y) + w1 * bflo(bq.y) + w2 * bflo(c.y), w0 * bfhi(a.y) + w1 * bfhi(bq.y) + w2 * bfhi(c.y));
        o.z = pk2(w0 * bflo(a.z) + w1 * bflo(bq.z) + w2 * bflo(c.z), w0 * bfhi(a.z) + w1 * bfhi(bq.z) + w2 * bfhi(c.z));
        o.w = pk2(w0 * bflo(a.w) + w1 * bflo(bq.w) + w2 * bflo(c.w), w0 * bfhi(a.w) + w1 * bfhi(bq.w) + w2 * bfhi(c.w));
        *(GAS v4u*)(Ob + (size_t)tok * OC + j * 64 + ch * 8) = o;
    }
    __syncthreads();
#undef SBAR
}

constexpr int MB_CNT = 64, MB_M = 1024, MB_L = 2048, MB_LIST = 3072, MB_TAB = 8192, MB_OST = 24576, MB_K = 90112, MB_V = 126976;
template <bool OWN>
__device__ __forceinline__ void moba_item(const bf16x8 q0, const bf16x8 q1, LAS unsigned char* lds, int lane, int qb, int n, int qid, bool valid, int smax) {
#define SBAR() __builtin_amdgcn_sched_barrier(0)
    const int i16 = lane & 15, g = lane >> 4;
    LAS float* Ost = (LAS float*)(lds + MB_OST); LAS float* mst = (LAS float*)(lds + MB_M); LAS float* lst = (LAS float*)(lds + MB_L);
    const LAS unsigned char* kbase = lds + MB_K + i16 * 144 + 16 * g;
    const LAS unsigned char* vbase = lds + MB_V + (4 * g + (i16 >> 2)) * 144 + 8 * (i16 & 3);
    f32x4 S[16];
#pragma unroll
    for (int sp = 0; sp < 4; ++sp) if (!OWN || 2 * sp <= smax) {
        bf16x8 kf[4][2];
#pragma unroll
        for (int t = 0; t < 4; ++t) { const LAS unsigned char* kp = kbase + (64 * sp + 32 * (t >> 1) + 16 * (t & 1)) * 144; kf[t][0] = *(const LAS bf16x8*)kp; kf[t][1] = *(const LAS bf16x8*)(kp + 64); }
        SBAR();
#pragma unroll
        for (int t = 0; t < 4; ++t) { f32x4 a = mfma16(kf[t][0], q0, (f32x4){0.f, 0.f, 0.f, 0.f}); S[4 * sp + t] = mfma16(kf[t][1], q1, a); }
        SBAR();
    }
    const float c2 = 0.125f * 1.4426950408889634f;
    const LAS float* tb = (const LAS float*)(lds + MB_TAB) + (256 * (qb - n) + qid - 4 * g - 255);
    float mx = NEGF;
#pragma unroll
    for (int sp = 0; sp < 4; ++sp) if (!OWN || 2 * sp <= smax) {
        float tv[16];
#pragma unroll
        for (int t = 0; t < 4; ++t)
#pragma unroll
            for (int jj = 0; jj < 4; ++jj) tv[4 * t + jj] = tb[255 - (64 * sp + 32 * (t >> 1) + 16 * (t & 1) + jj)];
        SBAR();
#pragma unroll
        for (int t = 0; t < 4; ++t)
#pragma unroll
            for (int jj = 0; jj < 4; ++jj) {
                float v = S[4 * sp + t][jj] * c2 + tv[4 * t + jj];
                if (OWN) { const int key = 64 * sp + 32 * (t >> 1) + 16 * (t & 1) + 4 * g + jj; v = (key <= qid) ? v : NEGF; }
                S[4 * sp + t][jj] = v; mx = fmaxf(mx, v);
            }
    }
    mx = fmaxf(mx, __shfl_xor(mx, 16)); mx = fmaxf(mx, __shfl_xor(mx, 32));
    float sum = 0.f;
#pragma unroll
    for (int sp = 0; sp < 4; ++sp) if (!OWN || 2 * sp <= smax) {
#pragma unroll
        for (int t = 0; t < 4; ++t)
#pragma unroll
            for (int jj = 0; jj < 4; ++jj) { const float pv = __builtin_amdgcn_exp2f(S[4 * sp + t][jj] - mx); S[4 * sp + t][jj] = pv; sum += pv; }
    }
    sum += __shfl_xor(sum, 16); sum += __shfl_xor(sum, 32);
    f32x4 O[4];
#pragma unroll
    for (int c = 0; c < 4; ++c) O[c] = (f32x4){0.f, 0.f, 0.f, 0.f};
#pragma unroll
    for (int s8 = 0; s8 < 8; ++s8) if (!OWN || (s8 >> 1) * 2 <= smax) {
        s16x4 vl[4][2];
#pragma unroll
        for (int c = 0; c < 4; ++c) { const LAS unsigned char* vp = vbase + (32 * s8) * 144 + 32 * c; vl[c][0] = vtr(vp); vl[c][1] = vtr(vp + 16 * 144); }
        const int t0 = 2 * s8; v4u pw; pw.x = pk2(S[t0][0], S[t0][1]); pw.y = pk2(S[t0][2], S[t0][3]); pw.z = pk2(S[t0 + 1][0], S[t0 + 1][1]); pw.w = pk2(S[t0 + 1][2], S[t0 + 1][3]);
        const bf16x8 pb = __builtin_bit_cast(bf16x8, pw);
        SBAR();
#pragma unroll
        for (int c = 0; c < 4; ++c) { const s16x4 lo = vl[c][0], hi = vl[c][1];
            const bf16x8 vf = (bf16x8){lo[0], lo[1], lo[2], lo[3], hi[0], hi[1], hi[2], hi[3]};
            O[c] = mfma16(vf, pb, O[c]); }
        SBAR();
    }
    if (valid) {
        LAS float* orow = Ost + qid * 64;
        if (OWN) {
#pragma unroll
            for (int c = 0; c < 4; ++c) *(LAS f32x4*)(orow + 4 * ((4 * c + g) ^ (qid & 15))) = O[c];
            if (g == 0) { mst[qid] = mx; lst[qid] = sum; }
        } else {
            const float mo = mst[qid], lo_ = lst[qid];
            f32x4 old[4];
#pragma unroll
            for (int c = 0; c < 4; ++c) old[c] = *(LAS f32x4*)(orow + 4 * ((4 * c + g) ^ (qid & 15)));
            const float mn = fmaxf(mo, mx), ao = __builtin_amdgcn_exp2f(mo - mn), ap = __builtin_amdgcn_exp2f(mx - mn);
#pragma unroll
            for (int c = 0; c < 4; ++c) *(LAS f32x4*)(orow + 4 * ((4 * c + g) ^ (qid & 15))) = old[c] * ao + O[c] * ap;
            if (g == 0) { mst[qid] = mn; lst[qid] = lo_ * ao + sum * ap; }
        }
    }
#undef SBAR
}
__device__ __forceinline__ void moba_unit(const Ctx& C, int unit, const float* KM) {
    const int qb = 15 - (unit >> 6), bh = unit & 63, b = bh >> 3, h = bh & 7;
    const bf16* Zb = (const bf16*)(C.ws + WS_Z) + (size_t)b * SEQ * ZC;
    LAS unsigned char* lds = C.lds - 64;
    LAS int* cnt = (LAS int*)(lds + MB_CNT);
    LAS unsigned char* lists = lds + MB_LIST;
    LAS float* tabC = (LAS float*)(lds + MB_TAB);
    LAS float* kml = (LAS float*)(lds + MB_K);
    const int lane = C.lane, i16 = lane & 15, tid = C.tid;
    const int ndist = 256 * qb + 256;
    {
        const float* TC = (const float*)(C.ws + WS_TABC) + h * 4096;
        float tv[8], kv[2]; v4u qv[8];
#pragma unroll
        for (int i = 0; i < 8; ++i) { const int d = tid + 512 * i; tv[i] = (d < ndist) ? TC[d] : 0.f; }
#pragma unroll
        for (int i = 0; i < 2; ++i) { const int e = tid + 512 * i; kv[i] = (e < qb * 64) ? KM[(size_t)(b * 16 + (e >> 6)) * 512 + h * 64 + (e & 63)] : 0.f; }
        if (tid < 256) { const bf16* qp = Zb + (size_t)(qb * 256 + tid) * ZC + QC + h * 64;
#pragma unroll
            for (int c = 0; c < 8; ++c) qv[c] = *(const v4u*)(qp + 8 * c); }
#pragma unroll
        for (int i = 0; i < 8; ++i) { const int d = tid + 512 * i; if (d < ndist) tabC[d] = tv[i]; }
#pragma unroll
        for (int i = 0; i < 2; ++i) { const int e = tid + 512 * i; if (e < qb * 64) kml[e] = kv[i] * (1.0f / 256.0f); }
        if (tid < 16) cnt[tid] = 0;
        __syncthreads();
        if (tid < 256) {
        float qf[64];
#pragma unroll
        for (int c = 0; c < 8; ++c) { const v4u w = qv[c];
            qf[8 * c + 0] = bflo(w.x); qf[8 * c + 1] = bfhi(w.x); qf[8 * c + 2] = bflo(w.y); qf[8 * c + 3] = bfhi(w.y);
            qf[8 * c + 4] = bflo(w.z); qf[8 * c + 5] = bfhi(w.z); qf[8 * c + 6] = bflo(w.w); qf[8 * c + 7] = bfhi(w.w); }
        float v1 = -3e38f, v2 = -3e38f, v3 = -3e38f; int i1 = -1, i2 = -1, i3 = -1;
        for (int n = 0; n < qb; ++n) {
            float s = 0.f;
#pragma unroll
            for (int e = 0; e < 64; ++e) s += qf[e] * kml[n * 64 + e];
            if (s > v1) { v3 = v2; i3 = i2; v2 = v1; i2 = i1; v1 = s; i1 = n; }
            else if (s > v2) { v3 = v2; i3 = i2; v2 = s; i2 = n; }
            else if (s > v3) { v3 = s; i3 = n; }
        }
        if (i1 >= 0) { const int pos = __hip_atomic_fetch_add(cnt + i1, 1, __ATOMIC_RELAXED, __HIP_MEMORY_SCOPE_WORKGROUP); lists[i1 * 256 + pos] = (unsigned char)tid; }
        if (i2 >= 0) { const int pos = __hip_atomic_fetch_add(cnt + i2, 1, __ATOMIC_RELAXED, __HIP_MEMORY_SCOPE_WORKGROUP); lists[i2 * 256 + pos] = (unsigned char)tid; }
        if (i3 >= 0) { const int pos = __hip_atomic_fetch_add(cnt + i3, 1, __ATOMIC_RELAXED, __HIP_MEMORY_SCOPE_WORKGROUP); lists[i3 * 256 + pos] = (unsigned char)tid; }
        }
    }
    v4u kreg[4], vreg[4];
#define MB_LOAD(nn) do { _Pragma("unroll") for (int i = 0; i < 4; ++i) { const int cidx = tid + 512 * i, row = cidx >> 3, ch = cidx & 7; \
        const bf16* src = Zb + (size_t)((nn) * 256 + row) * ZC + h * 64 + ch * 8; kreg[i] = *(const v4u*)(src + KC); vreg[i] = *(const v4u*)(src + VC); } } while (0)
#define MB_STORE() do { _Pragma("unroll") for (int i = 0; i < 4; ++i) { const int cidx = tid + 512 * i, row = cidx >> 3, ch = cidx & 7; \
        *(LAS v4u*)(lds + MB_K + row * 144 + ch * 16) = kreg[i]; *(LAS v4u*)(lds + MB_V + row * 144 + ch * 16) = vreg[i]; } } while (0)
#define MB_EXISTS(st, k) ((st) == 0 ? (k) < 2 : (C.wave + 8 * (k)) < ((cnt[(st) - 1] + 15) >> 4))
#define MB_QID(st, k, qid, valid) do { if ((st) == 0) { const int it_ = (k) ? 15 - C.wave : C.wave; qid = 16 * it_ + i16; valid = true; } \
        else { const int pos_ = 16 * (C.wave + 8 * (k)) + i16; valid = pos_ < cnt[(st) - 1]; qid = lists[((st) - 1) * 256 + (valid ? pos_ : 0)]; } } while (0)
#define MB_QLOAD(qid, d0, d1) do { const bf16* qp_ = Zb + (size_t)(qb * 256 + (qid)) * ZC + QC + h * 64 + 8 * (lane >> 4); d0 = *(const bf16x8*)qp_; d1 = *(const bf16x8*)(qp_ + 32); } while (0)
    MB_LOAD(qb);
    __syncthreads();
    for (int step = 0; step <= qb; ++step) {
        __syncthreads();
        MB_STORE();
        __syncthreads();
        if (step < qb) MB_LOAD(step);
#pragma unroll 1
        for (int k = 0; MB_EXISTS(step, k); ++k) {
            int cqid; bool cvalid; bf16x8 cq0, cq1;
            MB_QID(step, k, cqid, cvalid); MB_QLOAD(cqid, cq0, cq1);
            if (step == 0) { const int it = k ? 15 - C.wave : C.wave; moba_item<true>(cq0, cq1, lds, lane, qb, qb, cqid, true, (16 * it + 15) >> 5); }
            else moba_item<false>(cq0, cq1, lds, lane, qb, step - 1, cqid, cvalid, 7);
        }
    }
#undef MB_EXISTS
#undef MB_QID
#undef MB_QLOAD
#undef MB_LOAD
#undef MB_STORE
    __syncthreads();
    {
        const int qd = tid >> 1, hf = tid & 1;
        const LAS float* orow = (const LAS float*)(lds + MB_OST) + qd * 64; const float inv = __builtin_amdgcn_rcpf(((const LAS float*)(lds + MB_L))[qd]);
        bf16* op = (bf16*)(C.ws + WS_O) + (size_t)(b * SEQ + qb * 256 + qd) * OC + 768 + h * 64 + 32 * hf;
#pragma unroll
        for (int k = 0; k < 4; ++k) { const f32x4 a = *(const LAS f32x4*)(orow + 4 * ((8 * hf + 2 * k) ^ (qd & 15))), bq = *(const LAS f32x4*)(orow + 4 * ((8 * hf + 2 * k + 1) ^ (qd & 15)));
            v4u w; w.x = pk2(a[0] * inv, a[1] * inv); w.y = pk2(a[2] * inv, a[3] * inv); w.z = pk2(bq[0] * inv, bq[1] * inv); w.w = pk2(bq[2] * inv, bq[3] * inv);
            *(v4u*)(op + 8 * k) = w; }
    }
    __syncthreads();
}

__device__ __forceinline__ void lru_unit(const Ctx& C, const Params& p, int l, int unit) {
    const int tc = unit >> 6, b = (unit >> 3) & 7, nb = unit & 7, c0 = nb * 64;
    const bf16* Zb = (const bf16*)(C.ws + WS_Z) + (size_t)b * SEQ * ZC;
    bf16* Ob = (bf16*)(C.ws + WS_O) + (size_t)b * SEQ * OC;
    float* carr = (float*)(C.ws + WS_LC) + (size_t)(l * 1024) * 64;
    unsigned* flg = (unsigned*)(C.ws + WS_LF) + (size_t)(l * 1024) * 16;
    LAS unsigned char* XCB = C.lds;
    LAS float* RF = (LAS float*)(C.lds + 18432);
    LAS float* IF = (LAS float*)(C.lds + 18432 + 32768);
    LAS float* AGG = (LAS float*)(C.lds + 83968);
    LAS float* CAR = (LAS float*)(C.lds + 88064);
    LAS float* CARP = (LAS float*)(C.lds + 88320);
    LAS float* CIN = (LAS float*)(C.lds + 88576);
    LAS bf16* HL = (LAS bf16*)(C.lds + 90112);
    LAS bf16* PGL = (LAS bf16*)(C.lds + 122880);
    const int tid = C.tid, lane = C.lane, i16 = lane & 15, g = lane >> 4, c = tid & 63, tg = tid >> 6;
    const int ch = c0 + c;
    const float* cwp = p.in[4] + (size_t)l * 4 * 512;
    const float cw0 = cwp[ch], cw1 = cwp[512 + ch], cw2 = cwp[1024 + ch], cw3 = cwp[1536 + ch];
    const float cb = p.in[5][l * 512 + ch], ba = p.in[7][l * 512 + ch], bx = p.in[9][l * 512 + ch];
    const float lam = p.in[10][l * 512 + ch];
    const float logu = -8.0f * log1pf(expf(-lam));
    const bf16* WaT = (const bf16*)wla_ptr(C.ws, l) + nb * 4096;
    const bf16* WxT = (const bf16*)wlx_ptr(C.ws, l) + nb * 4096;
    bf16x8 wa[4][2], wx[4][2];
#pragma unroll
    for (int nt = 0; nt < 4; ++nt)
#pragma unroll
        for (int ks = 0; ks < 2; ++ks) { wa[nt][ks] = *(const bf16x8*)(WaT + (16 * nt + i16) * 64 + 32 * ks + 8 * g); wx[nt][ks] = *(const bf16x8*)(WxT + (16 * nt + i16) * 64 + 32 * ks + 8 * g); }
    if (tid < 64) { CAR[tid] = 0.f; CARP[tid] = 1.f; }
    __syncthreads();
#pragma unroll 1
    for (int tile = 0; tile < 2; ++tile) {
        const int tl0 = tile * 128 + 16 * tg, t0 = tc * 256 + tl0;
        float xw[19], gbv[16], xc[16];
#pragma unroll
        for (int k = 0; k < 19; ++k) { const int t = t0 - 3 + k; xw[k] = (t >= 0) ? bf2f(Zb[(size_t)t * ZC + XB + ch]) : 0.f; }
#pragma unroll
        for (int i = 0; i < 16; ++i) gbv[i] = bf2f(Zb[(size_t)(t0 + i) * ZC + GB + ch]);
#pragma unroll
        for (int i = 0; i < 16; ++i) { xc[i] = cb + cw0 * xw[i] + cw1 * xw[i + 1] + cw2 * xw[i + 2] + cw3 * xw[i + 3];
            *(LAS bf16*)(XCB + (16 * tg + i) * 144 + c * 2) = f2bf_hw(xc[i]); }
        __syncthreads();
        {
            const LAS unsigned char* ap = XCB + (16 * C.wave + i16) * 144 + 16 * g;
            const bf16x8 a0 = *(const LAS bf16x8*)ap, a1 = *(const LAS bf16x8*)(ap + 64);
#pragma unroll
            for (int nt = 0; nt < 4; ++nt) {
                f32x4 r = mfma16(a0, wa[nt][0], (f32x4){0.f, 0.f, 0.f, 0.f}); r = mfma16(a1, wa[nt][1], r);
                f32x4 x = mfma16(a0, wx[nt][0], (f32x4){0.f, 0.f, 0.f, 0.f}); x = mfma16(a1, wx[nt][1], x);
#pragma unroll
                for (int jj = 0; jj < 4; ++jj) { RF[(16 * C.wave + 4 * g + jj) * 64 + 16 * nt + i16] = r[jj]; IF[(16 * C.wave + 4 * g + jj) * 64 + 16 * nt + i16] = x[jj]; }
            }
        }
        __syncthreads();
        float av[16], bt[16]; float Ap = 1.f, hl = 0.f;
#pragma unroll
        for (int i = 0; i < 16; ++i) {
            const float r = sigmoidf_(RF[(16 * tg + i) * 64 + c] + ba), ig = sigmoidf_(IF[(16 * tg + i) * 64 + c] + bx);
            const float la = r * logu; av[i] = __expf(la);
            const float x2 = 2.0f * la;
            const float em = -x2 * (1.0f + x2 * (0.5f + x2 * (0.16666667f + x2 * (0.041666668f + x2 * (0.0083333338f + x2 * 0.0013888889f)))));
            bt[i] = __builtin_amdgcn_sqrtf(em) * (ig * xc[i]);
            Ap *= av[i]; hl = av[i] * hl + bt[i];
        }
        AGG[(tg * 64 + c) * 2] = Ap; AGG[(tg * 64 + c) * 2 + 1] = hl;
        __syncthreads();
        float hcur = CAR[c], pcur = CARP[c];
        for (int k = 0; k < tg; ++k) { const float ak = AGG[(k * 64 + c) * 2]; hcur = ak * hcur + AGG[(k * 64 + c) * 2 + 1]; pcur *= ak; }
#pragma unroll
        for (int i = 0; i < 16; ++i) {
            hcur = av[i] * hcur + bt[i]; pcur *= av[i];
            const float x = gbv[i], y = 0.7978845608028654f * (x + 0.044715f * x * x * x);
            const float th = 1.0f - 2.0f * __builtin_amdgcn_rcpf(__expf(2.0f * y) + 1.0f);
            const float ge = 0.5f * x * (1.0f + th);
            { const unsigned w2 = pk2(hcur * ge, pcur * ge); HL[(tl0 + i) * 64 + c] = (bf16)(w2 & 0xffffu); PGL[(tl0 + i) * 64 + c] = (bf16)(w2 >> 16); }
        }
        __syncthreads();
        if (tg == 7) { CAR[c] = hcur; CARP[c] = pcur; }
    }
    __syncthreads();
    if (tid < 64) {
        float cin = 0.f;
        if (tc > 0) {
            unsigned* pf = flg + (size_t)(unit - 64) * 16;
            while (__hip_atomic_load(pf, __ATOMIC_RELAXED, __HIP_MEMORY_SCOPE_AGENT) == 0u) __builtin_amdgcn_s_sleep(2);
            cin = __hip_atomic_load(carr + (size_t)(unit - 64) * 64 + tid, __ATOMIC_RELAXED, __HIP_MEMORY_SCOPE_AGENT);
        }
        CIN[tid] = cin;
        if (tc < 15) {
            __hip_atomic_store(carr + (size_t)unit * 64 + tid, CARP[tid] * cin + CAR[tid], __ATOMIC_RELAXED, __HIP_MEMORY_SCOPE_AGENT);
            asm volatile("s_waitcnt vmcnt(0)" ::: "memory");
            if (tid == 0) __hip_atomic_store(flg + (size_t)unit * 16, 1u, __ATOMIC_RELAXED, __HIP_MEMORY_SCOPE_AGENT);
        }
    }
    __syncthreads();
#pragma unroll
    for (int k = 0; k < 4; ++k) {
        const int w = tid + 512 * k, tl = w >> 3, cg8 = w & 7;
        const v4u hv = *(const LAS v4u*)(HL + tl * 64 + cg8 * 8), pv = *(const LAS v4u*)(PGL + tl * 64 + cg8 * 8);
        const f32x4 ci0 = *(const LAS f32x4*)(CIN + cg8 * 8), ci1 = *(const LAS f32x4*)(CIN + cg8 * 8 + 4);
        v4u o;
        o.x = pk2(bflo(hv.x) + bflo(pv.x) * ci0[0], bfhi(hv.x) + bfhi(pv.x) * ci0[1]);
        o.y = pk2(bflo(hv.y) + bflo(pv.y) * ci0[2], bfhi(hv.y) + bfhi(pv.y) * ci0[3]);
        o.z = pk2(bflo(hv.z) + bflo(pv.z) * ci1[0], bfhi(hv.z) + bfhi(pv.z) * ci1[1]);
        o.w = pk2(bflo(hv.w) + bflo(pv.w) * ci1[2], bfhi(hv.w) + bfhi(pv.w) * ci1[3]);
        *(v4u*)(Ob + (size_t)(tc * 256 + tl) * OC + 256 + c0 + cg8 * 8) = o;
    }
    __syncthreads();
}

#define XB_TMO      128
#define XB_XCNT(j)  (256  + 64 * (j))
#define XB_XSUB(j)  (1280 + 64 * (j))
#define XB_XGEN(j)  (2304 + 64 * (j))
#define XB_TOP      3328
#define XB_TOPGEN   3392
#define XCD_BAR_WORDS 3456
#define XB_SPIN_CAP (1u << 18)

__device__ __forceinline__ unsigned xb_ld(unsigned* p)              { return __hip_atomic_load(p, __ATOMIC_RELAXED, __HIP_MEMORY_SCOPE_AGENT); }
__device__ __forceinline__ unsigned xb_add(unsigned* p, unsigned v) { return __hip_atomic_fetch_add(p, v, __ATOMIC_RELAXED, __HIP_MEMORY_SCOPE_AGENT); }
__device__ __forceinline__ unsigned xb_xcc_id() { return (unsigned)__builtin_amdgcn_s_getreg((3 << 11) | 20) & 0xFu; }
#define XB_SPIN(cond, bar) do { unsigned _sp = 0; while (cond) { __builtin_amdgcn_s_sleep(1); \
    if ((++_sp & 255u) == 0u) { if (xb_ld(&(bar)[XB_TMO])) break; if (_sp > XB_SPIN_CAP) { atomicAdd(&(bar)[XB_TMO], 1u); break; } } } } while (0)

struct XcdBarrier {
    unsigned* bar; unsigned x;
    volatile LAS unsigned* st;
};

__device__ __forceinline__ XcdBarrier xcd_barrier_post(unsigned* bar, volatile LAS unsigned* st) {
    XcdBarrier b; b.bar = bar; b.x = xb_xcc_id(); b.st = st;
    if (threadIdx.x == 0) (void)xb_add(&bar[XB_XCNT(b.x)], 1u);
    return b;
}
__device__ __forceinline__ void xcd_barrier_complete(unsigned* bar, unsigned x, unsigned& nloc, unsigned& nx) {
    const unsigned G = gridDim.x * gridDim.y * gridDim.z;
    unsigned sum, cnt, mine, sp = 0u;
    for (;;) {
        sum = 0u; cnt = 0u; mine = 0u;
#pragma unroll
        for (unsigned j = 0; j < 16; ++j) { const unsigned c = xb_ld(&bar[XB_XCNT(j)]); sum += c; cnt += (c > 0u) ? 1u : 0u; mine = (j == x) ? c : mine; }
        if (sum == G) break;
        __builtin_amdgcn_s_sleep(1);
        if ((++sp & 255u) == 0u) { if (xb_ld(&bar[XB_TMO])) break; if (sp > XB_SPIN_CAP) { atomicAdd(&bar[XB_TMO], 1u); break; } }
    }
    nloc = mine > 0u ? mine : 1u; nx = cnt > 0u ? cnt : 1u;
}

__device__ __forceinline__ void xcd_barrier(const XcdBarrier& b) {
    asm volatile("s_waitcnt vmcnt(0)" ::: "memory");
    __syncthreads();
    if (threadIdx.x == 0) {
        unsigned* bar = b.bar;
        __builtin_amdgcn_s_waitcnt(0);
        unsigned nloc = b.st[0], nx = b.st[1];
        if (nloc == 0u) { xcd_barrier_complete(bar, b.x, nloc, nx); b.st[0] = nloc; b.st[1] = nx; }
        const unsigned old = xb_add(&bar[XB_XSUB(b.x)], 1u);
        const unsigned gen = old / nloc;
        if (old + 1u == (gen + 1u) * nloc) {
            __builtin_amdgcn_fence(__ATOMIC_RELEASE, "agent");
            asm volatile("s_waitcnt vmcnt(0)" ::: "memory");
            const unsigned og = xb_add(&bar[XB_TOP], 1u);
            const unsigned tg = og / nx;
            if (og + 1u == (tg + 1u) * nx) xb_add(&bar[XB_TOPGEN], 1u);
            else XB_SPIN(xb_ld(&bar[XB_TOPGEN]) == tg, bar);
            __builtin_amdgcn_fence(__ATOMIC_ACQUIRE, "agent");
            xb_add(&bar[XB_XGEN(b.x)], 1u);
            asm volatile("s_waitcnt vmcnt(0)" ::: "memory");
        } else {
            XB_SPIN(xb_ld(&bar[XB_XGEN(b.x)]) == gen, bar);
            __builtin_amdgcn_fence(__ATOMIC_ACQUIRE, "agent");
            asm volatile("s_waitcnt vmcnt(0)" ::: "memory");
        }
    }
    __syncthreads();
}

#define GSYNC() xcd_barrier(xbar)
#define MKCTX() Ctx C; size_t z_ = 0; { int t_ = threadIdx.x; asm volatile("" : "+s"(z_), "+v"(t_)); unsigned char* ws_ = p.ws + z_; const float* rb_ = p.in[1] + z_; \
    C.lds = (LAS unsigned char*)lds_raw + 64; C.tid = t_; C.lane = t_ & 63; C.wave = __builtin_amdgcn_readfirstlane(t_ >> 6); C.relb = rb_; C.ws = ws_; }
__global__ void __launch_bounds__(512) hybrid_fwd(Params p) {
    extern __shared__ __attribute__((aligned(16))) unsigned char lds_raw[];
    cg::grid_group grid = cg::this_grid();
    const int G = gridDim.x;
    if (threadIdx.x < 16) ((LAS unsigned*)lds_raw)[threadIdx.x] = 0u;
    __syncthreads();
    const XcdBarrier xbar = xcd_barrier_post((unsigned*)(p.ws + WS_CTL) + 16384, (volatile LAS unsigned*)((LAS unsigned char*)lds_raw + 16));
    volatile LAS int& s_unit = *(volatile LAS int*)(LAS unsigned char*)lds_raw;

#pragma nounroll
    for (int l = 0; l < 2; ++l) {
        { MKCTX(); const int gw = blockIdx.x * 8 + C.wave, NGW = G * 8;
          const float* xin = (l == 0) ? p.in[0] : p.out; xin += z_;
          bf16* Hb = (bf16*)(C.ws + WS_H);
          if (l == 0) { prep_weights(C, p, 0, gw, NGW, 0, PW_IN); prep_weights(C, p, 0, gw, NGW, PW_ALL, PW_END); }
          { int m = gw; for (; m + 3 * NGW < MTOK; m += 4 * NGW) rms_rows_bf16<4>(xin, p.in[2] + l * DM, Hb, m, NGW, C.lane); for (; m < MTOK; m += NGW) rms_rows_bf16<1>(xin, p.in[2] + l * DM, Hb, m, NGW, C.lane); }
          if (l == 0 && blockIdx.x < 8) { float* T = (float*)(C.ws + WS_TABC) + blockIdx.x * 4096; for (int d = C.tid; d < 4096; d += 512) T[d] = C.relb[rel_bucket_dev(d) * 20 + 12 + blockIdx.x] * 1.4426950408889634f; }
          if (l == 0 && blockIdx.x == 8) { float* T = (float*)(C.ws + WS_TABA); for (int idx = C.tid; idx < 12 * 132; idx += 512) { const int gj = idx / 132, dlt = idx % 132, grp = gj >> 2; T[idx] = C.relb[rel_bucket_dev((dlt > 128 ? 128 : dlt) << (2 * grp)) * 20 + gj]; } } }
        if (p.ws == nullptr) grid.sync();
        GSYNC();
#ifndef NO_P1
        { MKCTX(); pg8::Gemm gm{(const bf16*)(C.ws + WS_H), (const bf16*)win_ptr(C.ws, l), MTOK, ZC, 1024}; pg8::StaticOrder S; S.init(MTOK, ZC, G, (int)blockIdx.x);
          EpiZ E{(bf16*)(C.ws + WS_Z), (float*)(C.ws + WS_KM) + (size_t)l * 128 * 512};
          pg8::gemm_phase<EpiZ, pg8::StaticOrder, true, true>(C.lds, gm, S, E, 1024);
          { const int nwg = (MTOK / 256) * (ZC / 256), rounds = (nwg + G - 1) / G, rem = nwg - (rounds - 1) * G;
            const bool idle = rem < G; const int gwI = idle ? ((int)blockIdx.x - rem) * 8 + C.wave : (int)blockIdx.x * 8 + C.wave, ngwI = idle ? (G - rem) * 8 : G * 8;
            if (!idle || (int)blockIdx.x >= rem) { prep_weights(C, p, l, gwI, ngwI, PW_IN, PW_ALL);
                if (l == 0) { prep_weights(C, p, 1, gwI, ngwI, 0, PW_IN); prep_weights(C, p, 1, gwI, ngwI, PW_ALL, PW_END); } } } }
#endif
        GSYNC();
        for (;;) {
            MKCTX();
            unsigned* ctl = (unsigned*)(C.ws + WS_CTL);
            __syncthreads();
            if (C.tid == 0) s_unit = (int)atomicAdd(ctl + 64 * (1 + l), 1u);
            __syncthreads();
            const int u = s_unit;
            __syncthreads();
            if (u >= 1024 + 1024 + 512) break;
            const int v2 = u - 512, grpq = v2 >> 7, rq = v2 & 127;
#ifndef NO_LRU
            if (u >= 512 && rq < 64) lru_unit(C, p, l, grpq * 64 + rq);
#endif
#ifndef NO_MOBA
            if (u >= 512 && rq >= 64) moba_unit(C, grpq * 64 + (rq - 64), (const float*)(C.ws + WS_KM) + (size_t)l * 128 * 512);
#endif
#ifndef NO_A
            if (u < 512) attnA_unit(C, u);
#endif
        }
        GSYNC();
#ifndef NO_P3
        { MKCTX(); ProdOrder S; S.init(G, (int)blockIdx.x);
          pg8::Gemm gm{(const bf16*)(C.ws + WS_O), (const bf16*)(C.ws + WS_W + W_PA), MTOK, 3072, 512}; EpiTmp3 E{(bf16*)(C.ws + WS_TMP3)};
          pg8::gemm_phase<EpiTmp3, ProdOrder, true, true>(C.lds, gm, S, E, OC);
        }
        { MKCTX(); GateOrder S; S.init(G, (int)blockIdx.x);
          pg8::Gemm gm{(const bf16*)(C.ws + WS_H), (const bf16*)win_ptr(C.ws, l) + (size_t)ZC * 1024, MTOK, 3072, 1024}; EpiGate3 E{(bf16*)(C.ws + WS_TMP3)};
          pg8::gemm_phase<EpiGate3, GateOrder, true, true>(C.lds, gm, S, E, 1024); }
#endif
        GSYNC();
#ifndef NO_P4
        { MKCTX(); pg8::Gemm gm{(const bf16*)(C.ws + WS_TMP3), (const bf16*)(C.ws + WS_W + W_OUT), MTOK, DM, 1024}; pg8::StaticOrder S; S.init(MTOK, DM, G, (int)blockIdx.x);
          const float* xin = (l == 0) ? p.in[0] : p.out; float* xo = p.out; xin += z_; xo += z_;
          EpiResid E{xin, xo};
          pg8::gemm_phase<EpiResid, pg8::StaticOrder, true, true>(C.lds, gm, S, E, 3072); }
#endif
        GSYNC();
        { MKCTX(); const int gw = blockIdx.x * 8 + C.wave, NGW = G * 8; float* xo = p.out + z_; bf16* Hb = (bf16*)(C.ws + WS_H);
          { int m = gw; for (; m + 3 * NGW < MTOK; m += 4 * NGW) rms_rows_bf16<4>(xo, p.in[15] + l * DM, Hb, m, NGW, C.lane); for (; m < MTOK; m += NGW) rms_rows_bf16<1>(xo, p.in[15] + l * DM, Hb, m, NGW, C.lane); } }
        GSYNC();
#ifndef NO_P6
        { MKCTX(); pg8::Gemm gm{(const bf16*)(C.ws + WS_H), (const bf16*)(C.ws + WS_W + W_GU), MTOK, 5632, 1024}; pg8::StaticOrder S; S.init(MTOK, 5632, G, (int)blockIdx.x);
          EpiSwiGLU E{(bf16*)(C.ws + WS_FFH)};
          pg8::gemm_phase<EpiSwiGLU, pg8::StaticOrder, true, true>(C.lds, gm, S, E, 1024);
        }
#endif
        GSYNC();
#ifndef NO_P7
        { MKCTX(); pg8::Gemm gm{(const bf16*)(C.ws + WS_FFH), (const bf16*)(C.ws + WS_W + W_DOWN), MTOK, DM, FFN}; pg8::StaticOrder S; S.init(MTOK, DM, G, (int)blockIdx.x);
          float* xo = p.out + z_;
          EpiResid E{xo, xo};
          pg8::gemm_phase<EpiResid, pg8::StaticOrder, true, true>(C.lds, gm, S, E, FFN); }
#endif
        GSYNC();
    }
    { MKCTX(); const int gw = blockIdx.x * 8 + C.wave, NGW = G * 8; float* xo = p.out + z_;
      { int m = gw; for (; m + 3 * NGW < MTOK; m += 4 * NGW) rms_rows_f32<4>(xo, p.in[18], m, NGW, C.lane); for (; m < MTOK; m += NGW) rms_rows_f32<1>(xo, p.in[18], m, NGW, C.lane); } }
}

extern "C" void kernel_launch(void* const* d_in, const int* in_sizes, int n_in, void* d_out, int out_size, void* d_ws, size_t ws_size, hipStream_t stream) {
    static int grid_blocks = 0;
    if (grid_blocks == 0) {
        if (n_in != 19 || out_size != MTOK * DM || ws_size < WS_END) { fprintf(stderr, "kernel_launch: unexpected shapes: n_in %d out %d ws %zu (need %zu)\n", n_in, out_size, ws_size, (size_t)WS_END); grid_blocks = -1; return; }
        int dev = 0, cus = 0, per_cu = 0;
        (void)hipGetDevice(&dev);
        (void)hipDeviceGetAttribute(&cus, hipDeviceAttributeMultiprocessorCount, dev);
        if (hipFuncSetAttribute((const void*)hybrid_fwd, hipFuncAttributeMaxDynamicSharedMemorySize, LDS_BYTES) != hipSuccess) { fprintf(stderr, "kernel_launch: hipFuncSetAttribute failed\n"); grid_blocks = -1; return; }
        if (hipOccupancyMaxActiveBlocksPerMultiprocessor(&per_cu, (const void*)hybrid_fwd, 512, LDS_BYTES) != hipSuccess || per_cu < 1) { fprintf(stderr, "kernel_launch: occupancy query gave %d\n", per_cu); per_cu = 1; }
        (void)hipGetLastError();
        grid_blocks = cus * per_cu;
        fprintf(stderr, "kernel_launch: grid %d (cus %d x %d)\n", grid_blocks, cus, per_cu);
    }
    if (grid_blocks < 0) return;
    (void)hipMemsetAsync((char*)d_ws + WS_CTL, 0, CTL_BYTES, stream);
    Params p{};
    for (int i = 0; i < 19; ++i) p.in[i] = (const float*)d_in[i];
    p.out = (float*)d_out; p.ws = (unsigned char*)d_ws;
    void* args[] = {&p};
    hipError_t e = hipLaunchCooperativeKernel((const void*)hybrid_fwd, dim3(grid_blocks), dim3(512), args, LDS_BYTES, stream);
    if (e != hipSuccess) fprintf(stderr, "cooperative launch failed: %s (grid %d)\n", hipGetErrorString(e), grid_blocks);
}
```
